# Optimizing an MI355X kernel written in HIP

```python
import math
import jax, jax.numpy as jnp
from jax import lax
import numpy as np

D_MODEL = 2048
BATCH = 2
SEQ = 16384
DEPTH = 2

HEAD_DIM = 128
N_HEADS = D_MODEL // HEAD_DIM
N_HEADS_A = N_HEADS // 2
N_HEADS_B = N_HEADS - N_HEADS_A
WIDTH_A = N_HEADS_A * HEAD_DIM
WIDTH_B = N_HEADS_B * HEAD_DIM
DILATED_BRANCHES = ((128, 1), (512, 4), (2048, 16))
N_IDX_HEADS = 16
IDX_DIM = 64
TOPK_MAX = 256
Q_BLOCK = 128
D_FF = 5632
N_BUCKETS = 32
REL_MAX_DIST = 2048
EPS = 1e-6
PROJ_SIZES = (WIDTH_A, WIDTH_A, WIDTH_A, WIDTH_B, WIDTH_B, WIDTH_B,
              N_IDX_HEADS * IDX_DIM, IDX_DIM, N_IDX_HEADS)
PROJ_WIDTH = sum(PROJ_SIZES)
SPLIT_POINTS = tuple(int(c) for c in np.cumsum(PROJ_SIZES)[:-1])

kernel_name = "hybrid_dilated_dsa_macaron"


def rms_norm(x, g):
    xf = x.astype(jnp.float32)
    y = xf * lax.rsqrt(jnp.mean(xf * xf, axis=-1, keepdims=True) + EPS)
    return (y * g.astype(jnp.float32)).astype(x.dtype)


def swiglu(h, w_in, w_out):
    gate, up = jnp.split(h @ w_in, 2, axis=-1)
    return (jax.nn.silu(gate) * up) @ w_out


def rel_bucket(dist):
    exact = N_BUCKETS // 2
    df = jnp.maximum(dist, 1).astype(jnp.float32)
    large = exact + (jnp.log(df / exact) / math.log(REL_MAX_DIST / exact)
                     * (N_BUCKETS - exact)).astype(jnp.int32)
    large = jnp.minimum(large, N_BUCKETS - 1)
    return jnp.where(dist < exact, dist, large)


def dilated_branch(q, k, v, bias_tab, window, dil):
    B, S, H, E = q.shape
    blk = window // dil
    span = blk * dil
    s_pad = -(-S // span) * span
    nb = s_pad // span

    def to_blocks(t):
        t = jnp.pad(t, ((0, 0), (0, s_pad - S), (0, 0), (0, 0)))
        return t.reshape(B, nb, blk, dil, H, E)

    def with_prev(t):
        prev = jnp.pad(t, ((0, 0), (1, 0), (0, 0), (0, 0), (0, 0), (0, 0)))[:, :-1]
        return jnp.concatenate([prev, t], axis=2)

    qb = to_blocks(q)
    kw = with_prev(to_blocks(k))
    vw = with_prev(to_blocks(v))
    i = jnp.arange(blk)[:, None]
    j = jnp.arange(2 * blk)[None, :]
    step = blk + i - j
    band = (step >= 0) & (step <= blk)
    first = j >= blk
    nblock = jnp.arange(nb)[:, None, None, None, None]
    valid = band[None, None, None] & ((nblock > 0) | first[None, None, None])
    bias = bias_tab[rel_bucket(jnp.clip(step, 0, blk) * dil)]
    bias = jnp.transpose(bias, (2, 0, 1)).astype(jnp.float32)
    logits = jnp.einsum('bnidhe,bnjdhe->bndhij', qb, kw).astype(jnp.float32) + bias
    logits = jnp.where(valid, logits, -jnp.inf)
    lse = jax.nn.logsumexp(logits, axis=-1)
    p = jnp.exp(logits - lse[..., None])
    o = jnp.einsum('bndhij,bnjdhe->bnidhe', p.astype(v.dtype), vw)
    o = o.reshape(B, s_pad, H, E)[:, :S]
    lse = jnp.transpose(lse, (0, 1, 4, 2, 3)).reshape(B, s_pad, H)[:, :S]
    return o, lse


def dilated_mixer(q, k, v, bias_tab):
    outs, lses = [], []
    for window, dil in DILATED_BRANCHES:
        o, l = dilated_branch(q, k, v, bias_tab, window, dil)
        outs.append(o)
        lses.append(l)
    wts = jax.nn.softmax(jnp.stack(lses), axis=0)
    out = jnp.einsum('nbsh,nbshe->bshe', wts, jnp.stack(outs).astype(jnp.float32))
    return out.astype(q.dtype)


def dsa_mixer(q, k, v, q_idx, k_idx, w_idx, bias_tab):
    B, S, H, E = q.shape
    n_sel = min(TOPK_MAX, S // 4)
    nqb = S // Q_BLOCK
    key_pos = jnp.arange(S)
    idx_scale = (IDX_DIM ** -0.5) * (N_IDX_HEADS ** -0.5)

    def blocks(t):
        return jnp.moveaxis(t.reshape((B, nqb, Q_BLOCK) + t.shape[2:]), 1, 0)

    def one_block(args):
        qb, qib, wb, start = args
        t_pos = start + jnp.arange(Q_BLOCK)
        rel = jax.nn.relu(jnp.einsum('bthe,bse->bths', qib, k_idx).astype(jnp.float32))
        score = jnp.einsum('bths,bth->bts', rel, wb.astype(jnp.float32)) * idx_scale
        causal = key_pos[None, :] <= t_pos[:, None]
        score = jnp.where(causal, score, -jnp.inf)
        _, sel = lax.top_k(score, n_sel)
        valid = sel <= t_pos[None, :, None]
        kg = jax.vmap(lambda kk, ii: kk[ii])(k, sel)
        vg = jax.vmap(lambda vv, ii: vv[ii])(v, sel)
        logits = jnp.einsum('bthe,btkhe->bhtk', qb, kg).astype(jnp.float32)
        dist = jnp.maximum(t_pos[None, :, None] - sel, 0)
        bias = bias_tab[rel_bucket(dist)]
        logits = logits + jnp.transpose(bias, (0, 3, 1, 2)).astype(jnp.float32)
        logits = jnp.where(valid[:, None], logits, -jnp.inf)
        p = jax.nn.softmax(logits, axis=-1)
        return jnp.einsum('bhtk,btkhe->bthe', p.astype(v.dtype), vg)

    starts = jnp.arange(nqb, dtype=jnp.int32) * Q_BLOCK
    out = lax.map(one_block, (blocks(q), blocks(q_idx), blocks(w_idx), starts))
    return jnp.moveaxis(out, 0, 1).reshape(B, S, H, E)


def setup_inputs(seed: int = 0) -> dict:
    key = jax.random.key(seed)
    ks = jax.random.split(key, 16)
    nrm = lambda k, shape, fan_in: jax.random.normal(k, shape, jnp.float32) * (fan_in ** -0.5)
    gain = lambda k, shape: 1.0 + 0.05 * jax.random.normal(k, shape, jnp.float32)
    return {
        'x': jax.random.normal(ks[0], (BATCH, SEQ, D_MODEL), jnp.float32),
        'rel_bias': 0.2 * jax.random.normal(ks[1], (N_BUCKETS, N_HEADS), jnp.float32),
        'norm_ffn1': gain(ks[2], (DEPTH, D_MODEL)),
        'w_ffn1_in': nrm(ks[3], (DEPTH, D_MODEL, 2 * D_FF), D_MODEL),
        'w_ffn1_out': nrm(ks[4], (DEPTH, D_FF, D_MODEL), D_FF),
        'norm_mix': gain(ks[5], (DEPTH, D_MODEL)),
        'w_in': nrm(ks[6], (DEPTH, D_MODEL, PROJ_WIDTH), D_MODEL),
        'q_norm_a': gain(ks[7], (DEPTH, HEAD_DIM)),
        'k_norm_a': gain(ks[8], (DEPTH, HEAD_DIM)),
        'q_norm_b': gain(ks[9], (DEPTH, HEAD_DIM)),
        'k_norm_b': gain(ks[10], (DEPTH, HEAD_DIM)),
        'w_out': nrm(ks[11], (DEPTH, WIDTH_A + WIDTH_B, D_MODEL), WIDTH_A + WIDTH_B),
        'norm_ffn2': gain(ks[12], (DEPTH, D_MODEL)),
        'w_ffn2_in': nrm(ks[13], (DEPTH, D_MODEL, 2 * D_FF), D_MODEL),
        'w_ffn2_out': nrm(ks[14], (DEPTH, D_FF, D_MODEL), D_FF),
    }


def reference(x, rel_bias, norm_ffn1, w_ffn1_in, w_ffn1_out, norm_mix, w_in,
              q_norm_a, k_norm_a, q_norm_b, k_norm_b, w_out,
              norm_ffn2, w_ffn2_in, w_ffn2_out):
    B, S, _ = x.shape
    bias_a = rel_bias[:, :N_HEADS_A]
    bias_b = rel_bias[:, N_HEADS_A:]
    scale = HEAD_DIM ** -0.5
    heads = lambda t: t.reshape(B, S, -1, HEAD_DIM)
    for l in range(DEPTH):
        x = x + 0.5 * swiglu(rms_norm(x, norm_ffn1[l]), w_ffn1_in[l], w_ffn1_out[l])
        h = rms_norm(x, norm_mix[l])
        proj = h @ w_in[l]
        qa, ka, va, qb, kb, vb, qi, ki, wi = jnp.split(proj, SPLIT_POINTS, axis=-1)
        qa = rms_norm(heads(qa), q_norm_a[l]) * scale
        ka = rms_norm(heads(ka), k_norm_a[l])
        qb = rms_norm(heads(qb), q_norm_b[l]) * scale
        kb = rms_norm(heads(kb), k_norm_b[l])
        mix_a = dilated_mixer(qa, ka, heads(va), bias_a)
        mix_b = dsa_mixer(qb, kb, heads(vb), qi.reshape(B, S, N_IDX_HEADS, IDX_DIM),
                          ki, wi, bias_b)
        mixed = jnp.concatenate([mix_a.reshape(B, S, WIDTH_A), mix_b.reshape(B, S, WIDTH_B)], axis=-1)
        x = x + mixed @ w_out[l]
        x = x + 0.5 * swiglu(rms_norm(x, norm_ffn2[l]), w_ffn2_in[l], w_ffn2_out[l])
    return x
```

```cpp
#include <hip/hip_runtime.h>
#include <cstdio>
#include <cstdint>

#ifndef MK_ONE_LAUNCH
#define MK_ONE_LAUNCH 1
#endif

#define LAS __attribute__((address_space(3)))
#define GAS __attribute__((address_space(1)))
typedef unsigned short bf16_t;
typedef short bf16x8 __attribute__((ext_vector_type(8)));
typedef short s16x4 __attribute__((ext_vector_type(4)));
typedef float f32x4 __attribute__((ext_vector_type(4)));
typedef float f32x16 __attribute__((ext_vector_type(16)));
typedef unsigned u32x4 __attribute__((ext_vector_type(4)));
typedef unsigned u32x2 __attribute__((ext_vector_type(2)));

constexpr int BATCH = 2, SEQ = 16384, DM = 2048, DEPTH = 2, HD = 128, NHA = 8, NHB = 8, DFF = 5632, NIH = 16, IDIM = 64, TOPK = 256;
constexpr int MROWS = BATCH * SEQ;
constexpr int PROJW = 7248, PROJP = 7424;
constexpr float EPS = 1e-6f;
constexpr float SCALE = 0.08838834764831845f;
constexpr float LOG2E = 1.4426950408889634f;

constexpr size_t MiB = 1u << 20;
constexpr size_t WS_SS = 128 * 1024;
constexpr size_t WS_CTL = 0, CTL_ZERO_BYTES = WS_SS + 6 * (size_t)32768 * 4;
constexpr float SS_SCALE = 256.0f, SS_INV = 1.0f / (256.0f * 2048.0f);
constexpr size_t WS_TABD = 1 * MiB + 768 * 1024;
constexpr size_t WS_TABB = 1 * MiB + 832 * 1024;
constexpr size_t WS_W1I = 2 * MiB, WS_W1O = 46 * MiB, WS_WIN = 68 * MiB, WS_WOUT = 97 * MiB, WS_W2I = 105 * MiB, WS_W2O = 149 * MiB;
constexpr size_t WS_H = 176 * MiB;
constexpr size_t WS_MIX = 688 * MiB;
constexpr size_t WS_QA = 304 * MiB;
constexpr size_t TSTRIDE = (size_t)MROWS * 1024;
constexpr size_t WS_T7 = 752 * MiB;
constexpr size_t WS_MID = 304 * MiB;
constexpr size_t WS_MASK = 816 * MiB;
constexpr size_t MASK_B = 16 * 64 * 65 * 32;
constexpr size_t WS_OACC = 888 * MiB, WS_LACC = 1016 * MiB;
constexpr size_t WS_OACC2 = WS_H, WS_LACC2 = 882 * MiB;
constexpr size_t WS_KIC = 1017 * MiB, WS_WIC = 1021 * MiB;
constexpr size_t WS_END = 1022 * MiB;
static_assert(WS_MASK + 2 * 2 * MASK_B * 8 <= WS_LACC2 && WS_LACC2 + (size_t)MROWS * 8 * 4 <= WS_OACC, "mask buffers");
__host__ __device__ __forceinline__ size_t mask_off(int b, int q) { const int g = q >> 3; return (size_t)b * MASK_B + (size_t)(16 * g * (g + 1) + (q & 7) * (g + 1) * 4) * 32; }
constexpr int TABD_N = 384, TABB_N = 1760, TAB_OFF = 96, FAR_DIST = 1536;

constexpr int LDS_BYTES = 155648;
constexpr int MISC_OFF = 155648 - 256;

__device__ __forceinline__ unsigned cvt_pk_bf16(float lo, float hi) { unsigned r; asm volatile("v_cvt_pk_bf16_f32 %0, %1, %2" : "=v"(r) : "v"(lo), "v"(hi)); return r; }
__device__ __forceinline__ float bf_lo(unsigned w) { return __uint_as_float(w << 16); }
__device__ __forceinline__ float bf_hi(unsigned w) { return __uint_as_float(w & 0xffff0000u); }
template <int K> __device__ __forceinline__ unsigned lane_xor_u(unsigned v) {
    if constexpr (K == 1) return (unsigned)__builtin_amdgcn_update_dpp(0, (int)v, 0xB1, 0xF, 0xF, true);
    else if constexpr (K == 2) return (unsigned)__builtin_amdgcn_update_dpp(0, (int)v, 0x4E, 0xF, 0xF, true);
    else if constexpr (K == 32) { auto rr = __builtin_amdgcn_permlane32_swap(v, v, false, false); const unsigned lane = __builtin_amdgcn_mbcnt_hi(~0u, __builtin_amdgcn_mbcnt_lo(~0u, 0u)); return lane < 32u ? rr[1] : rr[0]; }
    else return (unsigned)__builtin_amdgcn_ds_swizzle((int)v, (K << 10) | 0x1F);
}
template <int K> __device__ __forceinline__ float lane_xor_f(float v) { return __uint_as_float(lane_xor_u<K>(__float_as_uint(v))); }
__device__ __forceinline__ float wave_sum(float v) {
    v += lane_xor_f<1>(v); v += lane_xor_f<2>(v); v += lane_xor_f<4>(v); v += lane_xor_f<8>(v); v += lane_xor_f<16>(v);
    { auto rr = __builtin_amdgcn_permlane32_swap(__float_as_uint(v), __float_as_uint(v), false, false); v = __uint_as_float(rr[0]) + __uint_as_float(rr[1]); }
    return v;
}
__device__ __forceinline__ unsigned wave_max_u(unsigned v) {
    unsigned x;
    x = lane_xor_u<1>(v); v = x > v ? x : v; x = lane_xor_u<2>(v); v = x > v ? x : v; x = lane_xor_u<4>(v); v = x > v ? x : v;
    x = lane_xor_u<8>(v); v = x > v ? x : v; x = lane_xor_u<16>(v); v = x > v ? x : v;
    { auto rr = __builtin_amdgcn_permlane32_swap(v, v, false, false); v = rr[0] > rr[1] ? rr[0] : rr[1]; }
    return v;
}
__device__ __forceinline__ int phase_tid(int wave0) { int lane; asm volatile("v_mbcnt_lo_u32_b32 %0, -1, 0\n\tv_mbcnt_hi_u32_b32 %0, -1, %0" : "=v"(lane), "+s"(wave0)); return wave0 * 64 + lane; }
__device__ __forceinline__ int launder_v(int t) { asm volatile("" : "+v"(t)); return t; }
#define LDS_WAIT() asm volatile("s_waitcnt lgkmcnt(0)" ::: "memory")
#define VM_WAIT() asm volatile("s_waitcnt vmcnt(0)" ::: "memory")

#define XB_TMO      128
#define XB_XCNT(j)  (256  + 64 * (j))
#define XB_XSUB(j)  (1280 + 64 * (j))
#define XB_XGEN(j)  (2304 + 64 * (j))
#define XB_TOP      3328
#define XB_TOPGEN   3392
#define XCD_BAR_WORDS 3456
#define XB_SPIN_CAP (1u << 22)
__device__ __forceinline__ unsigned xb_ld(unsigned* p)              { return __hip_atomic_load(p, __ATOMIC_RELAXED, __HIP_MEMORY_SCOPE_AGENT); }
__device__ __forceinline__ unsigned xb_add(unsigned* p, unsigned v) { return __hip_atomic_fetch_add(p, v, __ATOMIC_RELAXED, __HIP_MEMORY_SCOPE_AGENT); }
__device__ __forceinline__ unsigned xb_xcc_id() { return (unsigned)__builtin_amdgcn_s_getreg((3 << 11) | 20) & 0xFu; }
#define XB_SPIN(cond, bar) do { unsigned _sp = 0; while (cond) { __builtin_amdgcn_s_sleep(1); \
    if ((++_sp & 255u) == 0u) { if (xb_ld(&(bar)[XB_TMO])) break; if (_sp > XB_SPIN_CAP) { atomicAdd(&(bar)[XB_TMO], 1u); break; } } } } while (0)
struct XcdBarrier { unsigned* bar; unsigned x; volatile LAS unsigned* st; };
__device__ __forceinline__ XcdBarrier xcd_barrier_post(unsigned* bar, volatile LAS unsigned* st) {
    XcdBarrier b; b.bar = bar; b.x = xb_xcc_id(); b.st = st;
    if (threadIdx.x == 0) (void)xb_add(&bar[XB_XCNT(b.x)], 1u);
    return b;
}
__device__ __forceinline__ void xcd_barrier_complete(unsigned* bar, unsigned x, unsigned& nloc, unsigned& nx) {
    const unsigned G = gridDim.x * gridDim.y * gridDim.z;
    unsigned sum, cnt, mine, sp = 0u;
    for (;;) {
        sum = 0u; cnt = 0u; mine = 0u;
#pragma unroll
        for (unsigned j = 0; j < 16; ++j) { const unsigned c = xb_ld(&bar[XB_XCNT(j)]); sum += c; cnt += (c > 0u) ? 1u : 0u; mine = (j == x) ? c : mine; }
        if (sum == G) break;
        __builtin_amdgcn_s_sleep(1);
        if ((++sp & 255u) == 0u) { if (xb_ld(&bar[XB_TMO])) break; if (sp > XB_SPIN_CAP) { atomicAdd(&bar[XB_TMO], 1u); break; } }
    }
    nloc = mine > 0u ? mine : 1u; nx = cnt > 0u ? cnt : 1u;
}
__device__ __forceinline__ void xcd_barrier(const XcdBarrier& b) {
    asm volatile("s_waitcnt vmcnt(0)" ::: "memory");
    __syncthreads();
    if (threadIdx.x == 0) {
        unsigned* bar = b.bar;
        __builtin_amdgcn_s_waitcnt(0);
        unsigned nloc = b.st[0], nx = b.st[1];
        if (nloc == 0u) { xcd_barrier_complete(bar, b.x, nloc, nx); b.st[0] = nloc; b.st[1] = nx; }
        const unsigned old = xb_add(&bar[XB_XSUB(b.x)], 1u);
        const unsigned gen = old / nloc;
        if (old + 1u == (gen + 1u) * nloc) {
            __builtin_amdgcn_fence(__ATOMIC_RELEASE, "agent");
            asm volatile("s_waitcnt vmcnt(0)" ::: "memory");
            const unsigned og = xb_add(&bar[XB_TOP], 1u);
            const unsigned tg = og / nx;
            if (og + 1u == (tg + 1u) * nx) xb_add(&bar[XB_TOPGEN], 1u);
            else XB_SPIN(xb_ld(&bar[XB_TOPGEN]) == tg, bar);
            __builtin_amdgcn_fence(__ATOMIC_ACQUIRE, "agent");
            xb_add(&bar[XB_XGEN(b.x)], 1u);
            asm volatile("s_waitcnt vmcnt(0)" ::: "memory");
        } else {
            XB_SPIN(xb_ld(&bar[XB_XGEN(b.x)]) == gen, bar);
            __builtin_amdgcn_fence(__ATOMIC_ACQUIRE, "agent");
            asm volatile("s_waitcnt vmcnt(0)" ::: "memory");
        }
    }
    __syncthreads();
}

namespace pg8 {
constexpr int BM = 256, BK = 64, HALF = 128, HTB = HALF * BK * 2, STAGE_BYTES = 8 * HTB, NXCD = 8, WGM = 4;
__host__ __device__ __forceinline__ int lds_byte(int r, int c) { const int st = (r >> 4) * 2 + (c >> 5), rr = r & 15, cc = c & 31, ob = rr * 64 + cc * 2; return st * 1024 + (ob ^ (((ob >> 9) & 1) << 5)); }
__host__ __device__ __forceinline__ void stage_rc(int b, int& R, int& C) { const int st = b / 1024, sb = b % 1024, swz = sb ^ (((sb >> 9) & 1) << 5); R = (st >> 1) * 16 + swz / 64; C = (st & 1) * 32 + (swz % 64) / 2; }
__host__ __device__ __forceinline__ int perm32(int rho) { const int n = rho >> 4, i = rho & 15; return 8 * (i >> 2) + 4 * n + (i & 3); }
struct Unit { int pm, pn; };
struct Gemm { const bf16_t* A; const bf16_t* Bt; int M, N, K; };
struct StaticOrder {
    int nM, nN, nwg, G, c;
    __host__ __device__ void init(int M, int N, int G_, int c_) { nM = M / BM; nN = N / BM; nwg = nM * nN; G = G_; c = c_; }
    __host__ __device__ bool next(int i, Unit& u) const {
        const long L = (long)i * G + c; if (L >= nwg) return false;
        int wgid = (int)L; { const int q = nwg / NXCD, r = nwg % NXCD, xcd = wgid % NXCD, off = wgid / NXCD; wgid = (xcd < r ? xcd * (q + 1) : r * (q + 1) + (xcd - r) * q) + off; }
        const int nig = WGM * nN, gid = wgid / nig, fm = gid * WGM, gsz = (nM - fm) < WGM ? (nM - fm) : WGM;
        u.pm = fm + ((wgid % nig) % gsz); u.pn = (wgid % nig) / gsz; return true;
    }
    __device__ __forceinline__ void a_ready(const Unit&) const {}
    __device__ __forceinline__ void done(const Unit&) const {}
};
struct NoPre {};
template <bool XB> struct EpiResid {
    static constexpr bool PERM = true, AFTER_DRAIN = false; typedef NoPre Pre;
    __device__ __forceinline__ Pre pre(const Unit&, int, int) const { return Pre{}; }
    const float* base; float* out; int ldc; float alpha;
    bf16_t* xb; unsigned* ss;
    __device__ __forceinline__ void operator()(const f32x4 (&acc)[2][2][4][2], const Unit& u, int wr, int wc, int fr, int fq, const Pre&) const {
        const float* bp = base; float* op = out; bf16_t* xp = xb; unsigned* sp = ss;
        asm volatile("" : "+s"(bp), "+s"(op), "+s"(xp), "+s"(sp));
        const int row0 = u.pm * BM + wr * 64 + fr, col0 = u.pn * BM + wc * 32 + 8 * fq;
        f32x4 rb[4][2][2];
#define RLOAD(ai_, m_) do { const unsigned off_ = (unsigned)(row0 + (ai_) * HALF + (m_) * 16) * (unsigned)ldc + (unsigned)col0; \
        _Pragma("unroll") for (int bj = 0; bj < 2; ++bj) { rb[m_][bj][0] = *(const f32x4*)(bp + off_ + bj * HALF); rb[m_][bj][1] = *(const f32x4*)(bp + off_ + bj * HALF + 4); } } while (0)
#define RPROC(ai_, m_) do { const int row = row0 + (ai_) * HALF + (m_) * 16; const unsigned off = (unsigned)row * (unsigned)ldc + (unsigned)col0; float sq = 0.f; \
        _Pragma("unroll") for (int bj = 0; bj < 2; ++bj) { const f32x4 b0 = rb[m_][bj][0], b1 = rb[m_][bj][1]; \
            const f32x4 v0 = b0 + acc[ai_][bj][m_][0] * alpha, v1 = b1 + acc[ai_][bj][m_][1] * alpha; \
            *(f32x4*)(op + off + bj * HALF) = v0; *(f32x4*)(op + off + bj * HALF + 4) = v1; \
            if constexpr (XB) { u32x4 w; w.x = cvt_pk_bf16(v0[0], v0[1]); w.y = cvt_pk_bf16(v0[2], v0[3]); w.z = cvt_pk_bf16(v1[0], v1[1]); w.w = cvt_pk_bf16(v1[2], v1[3]); \
                *(u32x4*)(xp + off + bj * HALF) = w; \
                sq += ((v0[0] * v0[0] + v0[1] * v0[1]) + (v0[2] * v0[2] + v0[3] * v0[3])) + ((v1[0] * v1[0] + v1[1] * v1[1]) + (v1[2] * v1[2] + v1[3] * v1[3])); } } \
        if constexpr (XB) { sq += lane_xor_f<16>(sq); sq += lane_xor_f<32>(sq); if (fq == 0) __hip_atomic_fetch_add(sp + row, (unsigned)(sq * SS_SCALE + 0.5f), __ATOMIC_RELAXED, __HIP_MEMORY_SCOPE_AGENT); } } while (0)
#pragma unroll
        for (int m = 0; m < 4; ++m) RLOAD(0, m);
        asm volatile("" ::: "memory");
#pragma unroll
        for (int m = 0; m < 4; ++m) { RPROC(0, m); asm volatile("" ::: "memory"); RLOAD(1, m); asm volatile("" ::: "memory"); }
#pragma unroll
        for (int m = 0; m < 4; ++m) { RPROC(1, m); asm volatile("" ::: "memory"); }
#undef RLOAD
#undef RPROC
    }
};
__device__ __forceinline__ float silu_mul(float g, float u) { return g * __builtin_amdgcn_rcpf(1.0f + __builtin_amdgcn_exp2f(-g * LOG2E)) * u; }
struct RowSS { unsigned v[8]; };
__device__ __forceinline__ RowSS load_row_ss(const unsigned* ss, const Unit& u, int wr, int fr) {
    RowSS p; const unsigned* sp = ss + u.pm * BM + wr * 64 + fr;
    asm volatile("global_load_dword %0, %8, off\n\tglobal_load_dword %1, %8, off offset:64\n\tglobal_load_dword %2, %8, off offset:128\n\tglobal_load_dword %3, %8, off offset:192\n\t"
                 "global_load_dword %4, %8, off offset:512\n\tglobal_load_dword %5, %8, off offset:576\n\tglobal_load_dword %6, %8, off offset:640\n\tglobal_load_dword %7, %8, off offset:704"
                 : "=&v"(p.v[0]), "=&v"(p.v[1]), "=&v"(p.v[2]), "=&v"(p.v[3]), "=&v"(p.v[4]), "=&v"(p.v[5]), "=&v"(p.v[6]), "=&v"(p.v[7]) : "v"(sp) : "memory");
    return p;
}
struct EpiSwiglu {
    static constexpr bool PERM = true, AFTER_DRAIN = false; typedef RowSS Pre;
    bf16_t* O; int ldc; const unsigned* ss;
    __device__ __forceinline__ Pre pre(const Unit& u, int wr, int fr) const { return load_row_ss(ss, u, wr, fr); }
    __device__ __forceinline__ void operator()(const f32x4 (&acc)[2][2][4][2], const Unit& u, int wr, int wc, int fr, int fq, const Pre& P) const {
        const int row0 = u.pm * BM + wr * 64 + fr, col0 = u.pn * HALF + wc * 32 + 8 * fq;
#pragma unroll
        for (int ai = 0; ai < 2; ++ai)
#pragma unroll
            for (int m = 0; m < 4; ++m) { const int row = row0 + ai * HALF + m * 16; bf16_t* rowp = O + (size_t)row * ldc + col0;
                const float r = __builtin_amdgcn_rsqf((float)P.v[ai * 4 + m] * SS_INV + EPS);
                const f32x4 g0 = acc[ai][0][m][0] * r, g1 = acc[ai][0][m][1] * r, u0 = acc[ai][1][m][0] * r, u1 = acc[ai][1][m][1] * r;
                u32x4 w; w.x = cvt_pk_bf16(silu_mul(g0[0], u0[0]), silu_mul(g0[1], u0[1])); w.y = cvt_pk_bf16(silu_mul(g0[2], u0[2]), silu_mul(g0[3], u0[3]));
                w.z = cvt_pk_bf16(silu_mul(g1[0], u1[0]), silu_mul(g1[1], u1[1])); w.w = cvt_pk_bf16(silu_mul(g1[2], u1[2]), silu_mul(g1[3], u1[3]));
                *(u32x4*)rowp = w; }
    }
};
struct EpiProj {
    static constexpr bool PERM = true, AFTER_DRAIN = false; typedef RowSS Pre;
    bf16_t* T0; const unsigned* ss; bf16_t* kic; bf16_t* wic; LAS float* X;
    __device__ __forceinline__ Pre pre(const Unit& u, int wr, int fr) const { return load_row_ss(ss, u, wr, fr); }
    __device__ __forceinline__ void operator()(const f32x4 (&acc)[2][2][4][2], const Unit& u, int wr, int wc, int fr, int fq, const Pre& P) const {
        const int row0 = u.pm * BM + wr * 64 + fr;
        if (u.pn < 28) {
            const int t = u.pn >> 2; const bool nrm = (t == 0) | (t == 1) | (t == 3) | (t == 4);
            bf16_t* base = T0 + (size_t)t * TSTRIDE + (size_t)row0 * 1024 + (u.pn & 3) * BM + wc * 32 + 8 * fq;
            f32x4 g0 = {1.f, 1.f, 1.f, 1.f}, g1 = {1.f, 1.f, 1.f, 1.f};
            if (nrm) {
#pragma unroll
                for (int ai = 0; ai < 2; ++ai)
#pragma unroll
                    for (int m = 0; m < 4; ++m)
#pragma unroll
                        for (int bj = 0; bj < 2; ++bj) { const f32x4 a0 = acc[ai][bj][m][0], a1 = acc[ai][bj][m][1];
                            float s = ((a0[0] * a0[0] + a0[1] * a0[1]) + (a0[2] * a0[2] + a0[3] * a0[3])) + ((a1[0] * a1[0] + a1[1] * a1[1]) + (a1[2] * a1[2] + a1[3] * a1[3]));
                            s += lane_xor_f<16>(s); s += lane_xor_f<32>(s);
                            if (fq == 0) X[((ai * HALF + wr * 64 + m * 16 + fr) * 2 + bj) * 4 + wc] = s; }
                asm volatile("s_waitcnt lgkmcnt(0)" ::: "memory"); __builtin_amdgcn_s_barrier(); asm volatile("" ::: "memory");
                const LAS float* gp = X + 2048 + (t == 0 ? 0 : (t == 1 ? 128 : (t == 3 ? 256 : 384))) + wc * 32 + 8 * fq;
                g0 = *(const LAS f32x4*)gp; g1 = *(const LAS f32x4*)(gp + 4);
            }
            const float hsc = (t == 0 || t == 3) ? SCALE * LOG2E : 1.0f;
#pragma unroll
            for (int ai = 0; ai < 2; ++ai)
#pragma unroll
                for (int m = 0; m < 4; ++m) { bf16_t* rowp = base + (size_t)(ai * HALF + m * 16) * 1024; const float r = __builtin_amdgcn_rsqf((float)P.v[ai * 4 + m] * SS_INV + EPS);
#pragma unroll
                    for (int bj = 0; bj < 2; ++bj) { float rr = r;
                        if (nrm) { const f32x4 p4 = *(const LAS f32x4*)(X + ((ai * HALF + wr * 64 + m * 16 + fr) * 2 + bj) * 4);
                            const float tot = ((p4[0] + p4[1]) + (p4[2] + p4[3])) * (r * r);
                            rr = r * __builtin_amdgcn_rsqf(tot * (1.0f / HD) + EPS) * hsc; }
                        const f32x4 v0 = acc[ai][bj][m][0] * rr * g0, v1 = acc[ai][bj][m][1] * rr * g1;
                        u32x4 w; w.x = cvt_pk_bf16(v0[0], v0[1]); w.y = cvt_pk_bf16(v0[2], v0[3]); w.z = cvt_pk_bf16(v1[0], v1[1]); w.w = cvt_pk_bf16(v1[2], v1[3]);
                        *(u32x4*)(rowp + bj * HALF) = w; } }
        } else if (wc < 3) {
#pragma unroll
            for (int ai = 0; ai < 2; ++ai)
#pragma unroll
                for (int m = 0; m < 4; ++m) { const size_t row = (size_t)(row0 + ai * HALF + m * 16); const float r = __builtin_amdgcn_rsqf((float)P.v[ai * 4 + m] * SS_INV + EPS);
                    const f32x4 v0 = acc[ai][0][m][0] * r, v1 = acc[ai][0][m][1] * r;
                    u32x4 w; w.x = cvt_pk_bf16(v0[0], v0[1]); w.y = cvt_pk_bf16(v0[2], v0[3]); w.z = cvt_pk_bf16(v1[0], v1[1]); w.w = cvt_pk_bf16(v1[2], v1[3]);
                    if (wc < 2) *(u32x4*)(kic + row * 64 + wc * 32 + 8 * fq) = w; else if (fq < 2) *(u32x4*)(wic + row * 16 + 8 * fq) = w; }
        }
    }
};

template <class Epi, class Sched, bool ALIGN_EPI = false, bool SP2 = false>
__device__ __forceinline__ void gemm_phase(LAS unsigned char* lds, const Gemm g, const Sched& S, const Epi& E, const int tid) {
    const int wid = __builtin_amdgcn_readfirstlane(tid >> 6), lane = tid & 63, wr = wid >> 2, wc = wid & 3, fr = lane & 15, fq = lane >> 4;
    const int K = g.K, nt = K / BK;
    unsigned voffA[2], voffB[2];
#pragma unroll
    for (int i = 0; i < 2; ++i) { int R, C; stage_rc(tid * 16 + i * 8192, R, C); const int Rb = Epi::PERM ? ((R & ~31) + perm32(R & 31)) : R;
        voffA[i] = (unsigned)(R * K + C) * 2u; voffB[i] = (unsigned)(Rb * K + C) * 2u; }
    const size_t kstep = (size_t)(BK * 2);
    const size_t hstep = (size_t)HALF * K * 2;
    const size_t tstep = 2 * hstep;
    const unsigned ldsw = (unsigned)wid * 1024u;
    const int aoff = lds_byte(wr * 64 + fr, fq * 8), boff = lds_byte(wc * 32 + fr, fq * 8);
#define PG8_SA(b, h) (((b) * 2 + (h)) * HTB)
#define PG8_SB(b, h) ((4 + (b) * 2 + (h)) * HTB)
#define PG8_STAGE(bufoff, gbase, voff) do { _Pragma("unroll") for (int _i = 0; _i < 2; ++_i) \
        __builtin_amdgcn_global_load_lds((const unsigned*)((const char*)(gbase) + (voff)[_i]), (LAS unsigned*)(lds + (bufoff) + ldsw + _i * 8192), 16, 0, 0); } while (0)
#define PG8_LDA(dst, b, h) do { _Pragma("unroll") for (int m = 0; m < 4; ++m) _Pragma("unroll") for (int k = 0; k < 2; ++k) dst[m][k] = *(const LAS bf16x8*)(lds + PG8_SA(b, h) + aoff + m * 2048 + k * 1024); } while (0)
#define PG8_LDB(dst, b, h) do { _Pragma("unroll") for (int n = 0; n < 2; ++n) _Pragma("unroll") for (int k = 0; k < 2; ++k) dst[n][k] = *(const LAS bf16x8*)(lds + PG8_SB(b, h) + boff + n * 2048 + k * 1024); } while (0)
#define PG8_MMA(ai, bj, At, Bt) do { __builtin_amdgcn_s_setprio(1); _Pragma("unroll") for (int m = 0; m < 4; ++m) _Pragma("unroll") for (int n = 0; n < 2; ++n) _Pragma("unroll") for (int k = 0; k < 2; ++k) \
        acc[ai][bj][m][n] = __builtin_amdgcn_mfma_f32_16x16x32_bf16(Bt[n][k], At[m][k], acc[ai][bj][m][n], 0, 0, 0); __builtin_amdgcn_s_setprio(0); } while (0)
#define PG8_WAIT_V(n) asm volatile("s_waitcnt vmcnt(" #n ")" ::: "memory")
#define PG8_WAIT_L(n) asm volatile("s_waitcnt lgkmcnt(" #n ")" ::: "memory")
#define PG8_BAR __builtin_amdgcn_s_barrier()
#define PG8_SCHED __builtin_amdgcn_sched_barrier(0)
    Unit cur, nxt; int ui = 0;
    if (!S.next(0, cur)) return;
    f32x4 acc[2][2][4][2];
#pragma unroll
    for (int a = 0; a < 2; ++a)
#pragma unroll
        for (int b = 0; b < 2; ++b)
#pragma unroll
            for (int m = 0; m < 4; ++m)
#pragma unroll
                for (int n = 0; n < 2; ++n) acc[a][b][m][n] = (f32x4){0.f, 0.f, 0.f, 0.f};
    bf16x8 At[4][2], B0[2][2], B1[2][2];
    const char* cA = (const char*)g.A + (size_t)cur.pm * tstep; const char* cB = (const char*)g.Bt + (size_t)cur.pn * tstep;
    S.a_ready(cur);
    if constexpr (SP2) {
        PG8_STAGE(PG8_SB(0, 0), cB, voffB); PG8_STAGE(PG8_SB(0, 1), cB + hstep, voffB); PG8_STAGE(PG8_SA(0, 0), cA, voffA); PG8_STAGE(PG8_SA(0, 1), cA + hstep, voffA);
        if (wr == 1) PG8_BAR;
        PG8_WAIT_V(2); PG8_BAR;
        PG8_STAGE(PG8_SB(1, 0), cB + kstep, voffB); PG8_STAGE(PG8_SA(1, 0), cA + kstep, voffA); PG8_STAGE(PG8_SB(1, 1), cB + hstep + kstep, voffB);
        PG8_WAIT_V(6); PG8_BAR;
    } else {
        PG8_STAGE(PG8_SB(0, 0), cB, voffB); PG8_STAGE(PG8_SA(0, 0), cA, voffA); PG8_STAGE(PG8_SB(0, 1), cB + hstep, voffB); PG8_STAGE(PG8_SA(0, 1), cA + hstep, voffA);
        if (wr == 1) PG8_BAR;
        PG8_WAIT_V(4); PG8_BAR;
        PG8_STAGE(PG8_SB(1, 0), cB + kstep, voffB); PG8_STAGE(PG8_SA(1, 0), cA + kstep, voffA); PG8_STAGE(PG8_SB(1, 1), cB + hstep + kstep, voffB);
        PG8_WAIT_V(6); PG8_BAR;
    }
    for (;;) {
        const bool has_next = S.next(ui + 1, nxt);
        const typename Epi::Pre pre = E.pre(cur, wr, fr);
        const char* nA = has_next ? (const char*)g.A + (size_t)nxt.pm * tstep : cA; const char* nB = has_next ? (const char*)g.Bt + (size_t)nxt.pn * tstep : cB;
        for (int t = 0; t < nt; t += 2) {
            const bool last = (t == nt - 2);
            const char* a1 = cA + (size_t)(t + 1) * kstep;
            const char* a2 = last ? nA : cA + (size_t)(t + 2) * kstep; const char* b2 = last ? nB : cB + (size_t)(t + 2) * kstep;
            const char* a3 = a2 + kstep; const char* b3 = b2 + kstep;
            if (last && has_next) S.a_ready(nxt);
            if constexpr (SP2) {
            PG8_LDB(B0, 0, 0); PG8_LDB(B1, 0, 1); PG8_SCHED; PG8_LDA(At, 0, 0); PG8_STAGE(PG8_SA(1, 1), a1 + hstep, voffA);
            PG8_WAIT_V(8); PG8_WAIT_L(0); PG8_BAR; PG8_MMA(0, 0, At, B0); PG8_MMA(0, 1, At, B1); PG8_BAR; PG8_SCHED;
            PG8_LDA(At, 0, 1); PG8_STAGE(PG8_SB(0, 0), b2, voffB); PG8_STAGE(PG8_SB(0, 1), b2 + hstep, voffB); PG8_STAGE(PG8_SA(0, 0), a2, voffA);
            PG8_WAIT_V(8); PG8_WAIT_L(0); PG8_BAR; PG8_MMA(1, 0, At, B0); PG8_MMA(1, 1, At, B1); PG8_BAR; PG8_SCHED;
            PG8_LDB(B0, 1, 0); PG8_LDB(B1, 1, 1); PG8_SCHED; PG8_LDA(At, 1, 0); PG8_STAGE(PG8_SA(0, 1), a2 + hstep, voffA);
            PG8_WAIT_V(8); PG8_WAIT_L(0); PG8_BAR; PG8_MMA(0, 0, At, B0); PG8_MMA(0, 1, At, B1); PG8_BAR; PG8_SCHED;
            PG8_LDA(At, 1, 1); PG8_STAGE(PG8_SB(1, 0), b3, voffB); PG8_STAGE(PG8_SB(1, 1), b3 + hstep, voffB); PG8_STAGE(PG8_SA(1, 0), a3, voffA);
            PG8_WAIT_V(8); PG8_WAIT_L(0); PG8_BAR; PG8_MMA(1, 0, At, B0); PG8_MMA(1, 1, At, B1); PG8_BAR; PG8_SCHED;
            } else {
            PG8_LDB(B0, 0, 0); PG8_SCHED; PG8_LDA(At, 0, 0); PG8_STAGE(PG8_SA(1, 1), a1 + hstep, voffA);
            PG8_WAIT_L(8); PG8_BAR; PG8_WAIT_L(0); PG8_MMA(0, 0, At, B0); PG8_BAR; PG8_SCHED;
            PG8_LDB(B1, 0, 1); PG8_STAGE(PG8_SB(0, 0), b2, voffB);
            PG8_BAR; PG8_WAIT_L(0); PG8_MMA(0, 1, At, B1); PG8_BAR;
            PG8_LDA(At, 0, 1); PG8_STAGE(PG8_SA(0, 0), a2, voffA);
            PG8_BAR; PG8_WAIT_L(0); PG8_MMA(1, 0, At, B0); PG8_BAR; PG8_SCHED;
            PG8_STAGE(PG8_SB(0, 1), b2 + hstep, voffB);
            PG8_WAIT_V(6); PG8_BAR; PG8_MMA(1, 1, At, B1); PG8_BAR;
            PG8_LDB(B0, 1, 0); PG8_SCHED; PG8_LDA(At, 1, 0); PG8_STAGE(PG8_SA(0, 1), a2 + hstep, voffA);
            PG8_WAIT_L(8); PG8_BAR; PG8_WAIT_L(0); PG8_MMA(0, 0, At, B0); PG8_BAR; PG8_SCHED;
            PG8_LDB(B1, 1, 1); PG8_STAGE(PG8_SB(1, 0), b3, voffB);
            PG8_BAR; PG8_WAIT_L(0); PG8_MMA(0, 1, At, B1); PG8_BAR;
            PG8_LDA(At, 1, 1); PG8_STAGE(PG8_SA(1, 0), a3, voffA);
            PG8_BAR; PG8_WAIT_L(0); PG8_MMA(1, 0, At, B0); PG8_BAR; PG8_SCHED;
            PG8_STAGE(PG8_SB(1, 1), b3 + hstep, voffB);
            PG8_WAIT_V(6); PG8_BAR; PG8_MMA(1, 1, At, B1); PG8_BAR;
            }
        }
        if constexpr (ALIGN_EPI) { if (wr == 0) PG8_BAR; }
        if constexpr (!Epi::AFTER_DRAIN) { E(acc, cur, wr, wc, fr, fq, pre); S.done(cur); }
        if (!has_next) break;
#pragma unroll
        for (int a = 0; a < 2; ++a)
#pragma unroll
            for (int b = 0; b < 2; ++b)
#pragma unroll
                for (int m = 0; m < 4; ++m)
#pragma unroll
                    for (int n = 0; n < 2; ++n) acc[a][b][m][n] = (f32x4){0.f, 0.f, 0.f, 0.f};
        cur = nxt; cA = nA; cB = nB; ++ui;
        if constexpr (ALIGN_EPI) { if (wr == 1) PG8_BAR; }
    }
    PG8_WAIT_V(0);
    if constexpr (!ALIGN_EPI) { if (wr == 0) PG8_BAR; }
    PG8_BAR;
#undef PG8_SA
#undef PG8_SB
#undef PG8_STAGE
#undef PG8_LDA
#undef PG8_LDB
#undef PG8_MMA
#undef PG8_WAIT_V
#undef PG8_WAIT_L
#undef PG8_BAR
#undef PG8_SCHED
}
}

namespace att {
constexpr int D = 128, NW = 8, QBLK = 32, KVBLK = 64, QB = NW * QBLK;
constexpr int SHM_V = KVBLK * D * 2, SHM_K = KVBLK * D * 2;
constexpr int LDS_WS = 2 * SHM_V + 2 * SHM_K;
constexpr int LDS_TAB = LDS_WS + NW * 64 * 4;
constexpr int LDS_Q = LDS_TAB + 7168;
constexpr int ATT_LDS = LDS_Q + NW * 8192;
constexpr float C2 = LOG2E * SCALE;
#define KSWZ(row, colB) ((row) * 256 + ((colB) ^ (((row) & 7) << 4)))
#define SBAR() __builtin_amdgcn_sched_barrier(0)
__device__ __forceinline__ int v_st(int k, int c) { const int kk = (k & ~0xC) | ((k & 4) << 1) | ((k & 8) >> 1); return ((kk >> 3) * 4 + (c >> 5)) * 512 + ((kk & 7) * 32 + (c & 31)) * 2; }
__device__ __forceinline__ int v_rd_base(int lane) { return ((lane & 3) << 3) | (((lane >> 2) & 3) << 6) | (((lane >> 4) & 1) << 5) | (((lane >> 5) & 1) << 8); }
constexpr int v_rd_off(int d0, int ks, int half) { return d0 * 512 + ks * 4096 + half * 2048; }
__device__ __forceinline__ int crow(int r, int hi) { return (r & 3) + 8 * (r >> 2) + 4 * hi; }
__device__ __forceinline__ bf16x8 load8(const bf16_t* p) { return *reinterpret_cast<const bf16x8*>(p); }

__device__ __forceinline__ void mask_tile(f32x16& p0, f32x16& p1, int dq, unsigned W) {
    const float NEG = -__builtin_inff();
#pragma unroll
    for (int r = 0; r < 16; ++r) {
        const int c = (r & 3) + 8 * (r >> 2);
        if ((unsigned)(dq - c) >= W) p0[r] = NEG;
        if ((unsigned)(dq - c - 32) >= W) p1[r] = NEG;
    }
}
__device__ __forceinline__ void bias_tile(f32x16& p0, f32x16& p1, const float* tabL, int dq) {
    const float* bp = tabL + (dq + TAB_OFF - 59);
#pragma unroll
    for (int g = 0; g < 4; ++g) {
        float t0[4], t1[4];
#pragma unroll
        for (int i = 0; i < 4; ++i) { t0[i] = bp[59 - 8 * g - i]; t1[i] = bp[27 - 8 * g - i]; }
#pragma unroll
        for (int i = 0; i < 4; ++i) { p0[4 * g + i] += t0[i]; p1[4 * g + i] += t1[i]; }
        asm volatile("" ::: "memory");
    }
}
typedef unsigned u32x16 __attribute__((ext_vector_type(16)));
struct MaskT { u32x16 a, b, c, d; };
__device__ __forceinline__ float sel_mask(float v, unsigned lo, unsigned hi, float neg) {
    const unsigned long long m = ((unsigned long long)hi << 32) | lo;
    asm volatile("v_cndmask_b32_e64 %0, %1, %0, %2" : "+v"(v) : "v"(neg), "s"(m));
    return v;
}
__device__ __forceinline__ void mask_issue(MaskT& M, const unsigned long long* mt) {
    asm volatile("s_load_dwordx16 %0, %4, 0x0 glc\n\ts_load_dwordx16 %1, %4, 0x40 glc\n\ts_load_dwordx16 %2, %4, 0x80 glc\n\ts_load_dwordx16 %3, %4, 0xc0 glc" : "=&s"(M.a), "=&s"(M.b), "=&s"(M.c), "=&s"(M.d) : "s"(mt));
}
__device__ __forceinline__ void mask_wait(MaskT& M) { asm volatile("s_waitcnt lgkmcnt(0)" : "+s"(M.a), "+s"(M.b), "+s"(M.c), "+s"(M.d)); }
#define MSEL0(v, g, i) sel_mask(v, (g < 2 ? M.a : M.b)[2 * (4 * (g & 1) + i)], (g < 2 ? M.a : M.b)[2 * (4 * (g & 1) + i) + 1], neg)
#define MSEL1(v, g, i) sel_mask(v, (g < 2 ? M.c : M.d)[2 * (4 * (g & 1) + i)], (g < 2 ? M.c : M.d)[2 * (4 * (g & 1) + i) + 1], neg)
__device__ __forceinline__ void arg_tile_far(f32x16& p0, f32x16& p1, const MaskT& M, float neg) {
#pragma unroll
    for (int g = 0; g < 4; ++g) {
#pragma unroll
        for (int i = 0; i < 4; ++i) { p0[4 * g + i] = MSEL0(p0[4 * g + i], g, i); p1[4 * g + i] = MSEL1(p1[4 * g + i], g, i); }
        __builtin_amdgcn_sched_barrier(0);
    }
}
__device__ __forceinline__ void arg_tile_near(f32x16& p0, f32x16& p1, const float* tabL, int dq, const MaskT& M, float neg) {
    const float* bp = tabL + (dq + TAB_OFF - 59);
#pragma unroll
    for (int g = 0; g < 4; ++g) {
        float t0[4], t1[4];
#pragma unroll
        for (int i = 0; i < 4; ++i) { t0[i] = bp[59 - 8 * g - i]; t1[i] = bp[27 - 8 * g - i]; }
#pragma unroll
        for (int i = 0; i < 4; ++i) { p0[4 * g + i] = MSEL0(p0[4 * g + i] + t0[i], g, i); p1[4 * g + i] = MSEL1(p1[4 * g + i] + t1[i], g, i); }
        __builtin_amdgcn_sched_barrier(0);
    }
}
__device__ __forceinline__ void exp_half(f32x16& p) {
#pragma unroll
    for (int r = 0; r < 16; ++r) p[r] = __builtin_amdgcn_exp2f(p[r]);
}
constexpr float THR = 8.f;
__device__ __forceinline__ void partialSM(f32x16& p0, f32x16& p1, float& m_reg, float& mn, float& alpha) {
    float pmax = p0[0];
#pragma unroll
    for (int r = 1; r < 16; ++r) pmax = fmaxf(pmax, p0[r]);
#pragma unroll
    for (int r = 0; r < 16; ++r) pmax = fmaxf(pmax, p1[r]);
    { auto rr = __builtin_amdgcn_permlane32_swap(__float_as_uint(pmax), __float_as_uint(pmax), false, false);
      pmax = fmaxf(__uint_as_float(rr[0]), __uint_as_float(rr[1])); }
    if (__builtin_expect(__all((pmax - m_reg) * SCALE <= THR), 1)) { mn = m_reg; alpha = 1.f; }
    else { mn = fmaxf(m_reg, pmax); alpha = __builtin_amdgcn_exp2f((m_reg - mn) * C2); m_reg = mn; }
    const float mnL = -mn * C2;
#pragma unroll
    for (int r = 0; r < 16; ++r) p0[r] = fmaf(p0[r], C2, mnL);
#pragma unroll
    for (int r = 0; r < 16; ++r) p1[r] = fmaf(p1[r], C2, mnL);
#pragma unroll
    for (int r = 0; r < 16; ++r) p0[r] = __builtin_amdgcn_exp2f(p0[r]);
}
__device__ __forceinline__ void finishSM(f32x16& p0, f32x16& p1, float alpha, float& l_reg, bf16x8& pa0, bf16x8& pa1, bf16x8& pa2, bf16x8& pa3) {
#pragma unroll
    for (int r = 0; r < 16; ++r) p1[r] = __builtin_amdgcn_exp2f(p1[r]);
    float ps = 0;
#pragma unroll
    for (int r = 0; r < 16; ++r) ps += p0[r];
#pragma unroll
    for (int r = 0; r < 16; ++r) ps += p1[r];
    { auto rr = __builtin_amdgcn_permlane32_swap(__float_as_uint(ps), __float_as_uint(ps), false, false);
      ps = __uint_as_float(rr[0]) + __uint_as_float(rr[1]); }
    l_reg = l_reg * alpha + ps;
#define PK4(P, B_, OUT) do { unsigned a0 = cvt_pk_bf16(P[B_+0], P[B_+1]), a1 = cvt_pk_bf16(P[B_+2], P[B_+3]);                          \
        unsigned b0 = cvt_pk_bf16(P[B_+4], P[B_+5]), b1 = cvt_pk_bf16(P[B_+6], P[B_+7]);                                             \
        auto r0 = __builtin_amdgcn_permlane32_swap(a0, b0, false, false); auto r1 = __builtin_amdgcn_permlane32_swap(a1, b1, false, false); \
        u32x4 w = {r0[0], r1[0], r0[1], r1[1]}; OUT = *reinterpret_cast<bf16x8*>(&w); } while (0)
    PK4(p0, 0, pa0); PK4(p0, 8, pa1); PK4(p1, 0, pa2); PK4(p1, 8, pa3);
#undef PK4
}
__device__ __forceinline__ void finishSM1(f32x16& p0, f32x16& p1, float& l_reg, bf16x8& pa0, bf16x8& pa1, bf16x8& pa2, bf16x8& pa3) {
    exp_half(p1);
    float ps = 0;
#pragma unroll
    for (int r = 0; r < 16; ++r) ps += p0[r];
#pragma unroll
    for (int r = 0; r < 16; ++r) ps += p1[r];
    { auto rr = __builtin_amdgcn_permlane32_swap(__float_as_uint(ps), __float_as_uint(ps), false, false);
      ps = __uint_as_float(rr[0]) + __uint_as_float(rr[1]); }
    l_reg += ps;
#define PK4(P, B_, OUT) do { unsigned a0 = cvt_pk_bf16(P[B_+0], P[B_+1]), a1 = cvt_pk_bf16(P[B_+2], P[B_+3]);                          \
        unsigned b0 = cvt_pk_bf16(P[B_+4], P[B_+5]), b1 = cvt_pk_bf16(P[B_+6], P[B_+7]);                                             \
        auto r0 = __builtin_amdgcn_permlane32_swap(a0, b0, false, false); auto r1 = __builtin_amdgcn_permlane32_swap(a1, b1, false, false); \
        u32x4 w = {r0[0], r1[0], r0[1], r1[1]}; OUT = *reinterpret_cast<bf16x8*>(&w); } while (0)
    PK4(p0, 0, pa0); PK4(p0, 8, pa1); PK4(p1, 0, pa2); PK4(p1, 8, pa3);
#undef PK4
}
template <int KB, bool SK, bool QREG>
__device__ __forceinline__ void qkt(f32x16& p0, f32x16& p1, const char* K_lds, int r32, int hi, const char* qb, const bf16x8* qr, bool act, float init) {
    if (SK && !act) { const float NEG = -__builtin_inff();
#pragma unroll
        for (int r = 0; r < 16; ++r) { p0[r] = NEG; p1[r] = NEG; } return; }
#pragma unroll
    for (int r = 0; r < 16; ++r) { p0[r] = init; p1[r] = init; }
    const char* kb[4];
#pragma unroll
    for (int dd = 0; dd < 4; ++dd) kb[dd] = K_lds + KB * SHM_K + KSWZ(r32, (dd * 16 + hi * 8) * 2);
#pragma unroll
    for (int d0 = 0; d0 < 8; ++d0) { const char* a = kb[d0 & 3] + (d0 >> 2) * 128;
        bf16x8 b0 = *reinterpret_cast<const bf16x8*>(a);
        bf16x8 b1 = *reinterpret_cast<const bf16x8*>(a + 32 * 256);
        const bf16x8 q = QREG ? qr[d0] : *reinterpret_cast<const bf16x8*>(qb + d0 * 1024);
        p0 = __builtin_amdgcn_mfma_f32_32x32x16_bf16(b0, q, p0, 0, 0, 0);
        p1 = __builtin_amdgcn_mfma_f32_32x32x16_bf16(b1, q, p1, 0, 0, 0); }
}
template <int VB, bool SK>
__device__ __forceinline__ void pv_tile(f32x16* o, int vb0, bf16x8 pa0, bf16x8 pa1, bf16x8 pa2, bf16x8 pa3, bool act) {
    if (SK && !act) return;
#define TRRD(dst, off) asm volatile("ds_read_b64_tr_b16 %0, %1 offset:%2" : "=&v"(dst) : "v"(vb0), "i"(off) : "memory")
#define PV_D0(d0) do { s16x4 l0, l1, l2, l3, h0, h1, h2, h3; constexpr int b_ = VB * SHM_V + v_rd_off(d0, 0, 0); \
        TRRD(l0, b_); TRRD(h0, b_ + 2048); TRRD(l1, b_ + 4096); TRRD(h1, b_ + 6144); TRRD(l2, b_ + 8192); TRRD(h2, b_ + 10240); TRRD(l3, b_ + 12288); TRRD(h3, b_ + 14336); \
        asm volatile("s_waitcnt lgkmcnt(0)" ::: "memory"); SBAR(); \
        o[d0] = __builtin_amdgcn_mfma_f32_32x32x16_bf16(pa0, (bf16x8){l0[0], l0[1], l0[2], l0[3], h0[0], h0[1], h0[2], h0[3]}, o[d0], 0, 0, 0);   \
        o[d0] = __builtin_amdgcn_mfma_f32_32x32x16_bf16(pa1, (bf16x8){l1[0], l1[1], l1[2], l1[3], h1[0], h1[1], h1[2], h1[3]}, o[d0], 0, 0, 0);   \
        o[d0] = __builtin_amdgcn_mfma_f32_32x32x16_bf16(pa2, (bf16x8){l2[0], l2[1], l2[2], l2[3], h2[0], h2[1], h2[2], h2[3]}, o[d0], 0, 0, 0);   \
        o[d0] = __builtin_amdgcn_mfma_f32_32x32x16_bf16(pa3, (bf16x8){l3[0], l3[1], l3[2], l3[3], h3[0], h3[1], h3[2], h3[3]}, o[d0], 0, 0, 0); } while (0)
    PV_D0(0); PV_D0(1); PV_D0(2); PV_D0(3);
#undef PV_D0
#undef TRRD
}

template <int KB, bool SK>
__device__ __forceinline__ void qkt_fsm1(f32x16& x0, f32x16& x1, const char* K_lds, int r32, int hi, const bf16x8* qr, float init,
                                         f32x16& y0, f32x16& y1, float& l_reg, bf16x8& pa0, bf16x8& pa1, bf16x8& pa2, bf16x8& pa3, bool act) {
    if (SK && !act) { const float NEG = -__builtin_inff();
#pragma unroll
        for (int r = 0; r < 16; ++r) { x0[r] = NEG; x1[r] = NEG; }
        finishSM1(y0, y1, l_reg, pa0, pa1, pa2, pa3); return; }
#pragma unroll
    for (int r = 0; r < 16; ++r) { x0[r] = init; x1[r] = init; }
    const char* kb[4];
#pragma unroll
    for (int dd = 0; dd < 4; ++dd) kb[dd] = K_lds + KB * SHM_K + KSWZ(r32, (dd * 16 + hi * 8) * 2);
    bf16x8 k0 = *reinterpret_cast<const bf16x8*>(kb[0]), k1 = *reinterpret_cast<const bf16x8*>(kb[0] + 32 * 256);
    float ps = 0.f;
#define PK4(P, B_, OUT) do { unsigned a0 = cvt_pk_bf16(P[B_+0], P[B_+1]), a1 = cvt_pk_bf16(P[B_+2], P[B_+3]);                          \
        unsigned b0 = cvt_pk_bf16(P[B_+4], P[B_+5]), b1 = cvt_pk_bf16(P[B_+6], P[B_+7]);                                             \
        auto r0 = __builtin_amdgcn_permlane32_swap(a0, b0, false, false); auto r1 = __builtin_amdgcn_permlane32_swap(a1, b1, false, false); \
        u32x4 w = {r0[0], r1[0], r0[1], r1[1]}; OUT = *reinterpret_cast<bf16x8*>(&w); } while (0)
#pragma unroll
    for (int d0 = 0; d0 < 8; ++d0) {
        x0 = __builtin_amdgcn_mfma_f32_32x32x16_bf16(k0, qr[d0], x0, 0, 0, 0);
        x1 = __builtin_amdgcn_mfma_f32_32x32x16_bf16(k1, qr[d0], x1, 0, 0, 0);
        if (d0 + 1 < 8) { const char* a = kb[(d0 + 1) & 3] + ((d0 + 1) >> 2) * 128; k0 = *reinterpret_cast<const bf16x8*>(a); k1 = *reinterpret_cast<const bf16x8*>(a + 32 * 256); }
        SBAR();
        if (d0 < 4) {
#pragma unroll
            for (int i = 0; i < 4; ++i) { y1[4 * d0 + i] = __builtin_amdgcn_exp2f(y1[4 * d0 + i]); ps += y0[4 * d0 + i]; }
        } else if (d0 == 4) {
#pragma unroll
            for (int i = 0; i < 8; ++i) ps += y1[i];
        } else if (d0 == 5) {
#pragma unroll
            for (int i = 8; i < 16; ++i) ps += y1[i];
            auto rr = __builtin_amdgcn_permlane32_swap(__float_as_uint(ps), __float_as_uint(ps), false, false);
            l_reg += __uint_as_float(rr[0]) + __uint_as_float(rr[1]);
        } else if (d0 == 6) { PK4(y0, 0, pa0); PK4(y0, 8, pa1); }
        else { PK4(y1, 0, pa2); PK4(y1, 8, pa3); }
        SBAR();
    }
#undef PK4
}
template <int VB>
__device__ __forceinline__ void pv_maskt1(f32x16* o, int vb0, bf16x8 pa0, bf16x8 pa1, bf16x8 pa2, bf16x8 pa3, f32x16& x0, f32x16& x1, MaskT& M, float neg) {
#define TRRD(dst, off) asm volatile("ds_read_b64_tr_b16 %0, %1 offset:%2" : "=&v"(dst) : "v"(vb0), "i"(off) : "memory")
#define PV_D0(d0) do { s16x4 l0, l1, l2, l3, h0, h1, h2, h3; constexpr int b_ = VB * SHM_V + v_rd_off(d0, 0, 0); \
        TRRD(l0, b_); TRRD(h0, b_ + 2048); TRRD(l1, b_ + 4096); TRRD(h1, b_ + 6144); TRRD(l2, b_ + 8192); TRRD(h2, b_ + 10240); TRRD(l3, b_ + 12288); TRRD(h3, b_ + 14336); \
        asm volatile("s_waitcnt lgkmcnt(0)" ::: "memory"); SBAR(); \
        o[d0] = __builtin_amdgcn_mfma_f32_32x32x16_bf16(pa0, (bf16x8){l0[0], l0[1], l0[2], l0[3], h0[0], h0[1], h0[2], h0[3]}, o[d0], 0, 0, 0);   \
        o[d0] = __builtin_amdgcn_mfma_f32_32x32x16_bf16(pa1, (bf16x8){l1[0], l1[1], l1[2], l1[3], h1[0], h1[1], h1[2], h1[3]}, o[d0], 0, 0, 0);   \
        o[d0] = __builtin_amdgcn_mfma_f32_32x32x16_bf16(pa2, (bf16x8){l2[0], l2[1], l2[2], l2[3], h2[0], h2[1], h2[2], h2[3]}, o[d0], 0, 0, 0);   \
        o[d0] = __builtin_amdgcn_mfma_f32_32x32x16_bf16(pa3, (bf16x8){l3[0], l3[1], l3[2], l3[3], h3[0], h3[1], h3[2], h3[3]}, o[d0], 0, 0, 0); SBAR(); } while (0)
#define MQ(g) do { _Pragma("unroll") for (int i = 0; i < 4; ++i) { x0[4 * (g) + i] = __builtin_amdgcn_exp2f(MSEL0(x0[4 * (g) + i], (g), i)); x1[4 * (g) + i] = MSEL1(x1[4 * (g) + i], (g), i); } SBAR(); } while (0)
    PV_D0(0); PV_D0(1); mask_wait(M); MQ(0); PV_D0(2); MQ(1); PV_D0(3); MQ(2); MQ(3);
#undef MQ
#undef PV_D0
#undef TRRD
}

struct Blk { int tok0, h, P0; };
struct Seam { bf16x8 qr[8]; bf16x8 st0, st1; };
template <int MODE> struct PhaseP {
    const bf16_t* Q; const bf16_t* K; const bf16_t* V;
    int tstep, skv, W;
    const float* tab;
    bf16_t* Oacc; float* Lacc; bf16_t* Oacc2; float* Lacc2; bf16_t* Out; int pass;
    const unsigned long long* mask; const float* farb;
};
__device__ __forceinline__ int swa_jlo(int P0, int W) { const int lowk = P0 - W + 1; return lowk > 0 ? lowk / KVBLK : 0; }
#define AROW(p, b, m) ((p) + ((size_t)((b).tok0 + (m) * P.tstep) * 1024 + (b).h * 128))
#define VMW() asm volatile("s_waitcnt vmcnt(0)" ::: "memory")
#define VMWN(n) asm volatile("s_waitcnt vmcnt(%0)" :: "i"(n) : "memory")
#define UROW(p, b, m) ((const char*)((p) + ((size_t)((b).tok0 + (m) * P.tstep) * 1024 + (b).h * 128)))
#define SLOAD_K(b, k0) do { const char* kp_ = UROW(P.K, b, k0); S.st0 = *(const bf16x8*)(kp_ + loff0); S.st1 = *(const bf16x8*)(kp_ + loff1); } while (0)
#define SLOAD_V(b, k0) do { const char* vp_ = UROW(P.V, b, k0); S.st0 = *(const bf16x8*)(vp_ + loff0); S.st1 = *(const bf16x8*)(vp_ + loff1); } while (0)
#define QLOAD(b) do { const char* qp_ = UROW(P.Q, b, (b).P0 + wid * QBLK); _Pragma("unroll") for (int d0 = 0; d0 < 8; ++d0) S.qr[d0] = *(const bf16x8*)(qp_ + qoff + d0 * 32); } while (0)
#define LANE_OFFS() const unsigned loff0 = (unsigned)(sr * P.tstep * 1024 + sc) * 2u, loff1 = loff0 + (unsigned)(32 * P.tstep) * 2048u, qoff = (unsigned)(r32 * P.tstep * 1024 + hi * 8) * 2u
#define SWRITE_K(bf) do { *(bf16x8*)(K_lds + (bf) * SHM_K + kws) = S.st0; *(bf16x8*)(K_lds + (bf) * SHM_K + kws + 32 * 256) = S.st1; } while (0)
#define SWRITE_VO(off) do { *(bf16x8*)(V_lds + (off) + vst0) = S.st0; *(bf16x8*)(V_lds + (off) + vst1) = S.st1; } while (0)
template <int MODE>
__device__ __forceinline__ void attn_prime(const PhaseP<MODE>& P, const Blk& cur, char* lds, Seam& S, const int tid) {
    const int wid = __builtin_amdgcn_readfirstlane(tid >> 6), lane = tid & 63, r32 = lane & 31, hi = lane >> 5;
    const int sr = tid >> 4, sc = (tid & 15) * 8, kws = KSWZ(sr, sc * 2); char* K_lds = lds + 2 * SHM_V;
    const int kb0 = swa_jlo(cur.P0, P.W) * KVBLK;
    LANE_OFFS();
    QLOAD(cur);
    SLOAD_K(cur, kb0); VMW(); SWRITE_K(0); SBAR(); SLOAD_V(cur, kb0);
    __syncthreads();
}
template <int MODE>
__device__ __forceinline__ void attn_block(const PhaseP<MODE>& P, const Blk& cur, const Blk& nxt, char* lds, Seam& S, const int tid_phase) {
    const int tid = launder_v(tid_phase);
    const int wid = __builtin_amdgcn_readfirstlane(tid >> 6), lane = tid & 63, r32 = lane & 31, hi = lane >> 5;
    const int W = P.W, skv = P.skv;
    const int j_lo = swa_jlo(cur.P0, W);
    int j_hi = (cur.P0 + QB - 1) / KVBLK + 1; if (j_hi > skv / KVBLK) j_hi = skv / KVBLK;
    const int NT = j_hi - j_lo;
    const int kbn = swa_jlo(nxt.P0, W) * KVBLK;
    const int qlo = cur.P0 + wid * QBLK, qm = qlo + r32 - 4 * hi;
    char* V_lds = lds; char* K_lds = lds + 2 * SHM_V;
    float* ws = (float*)(lds + LDS_WS) + wid * 64; float* li_l = ws, * al_l = ws + 32;
    float* tabL = (float*)(lds + LDS_TAB);
    char* qb = lds + LDS_Q + wid * 8192 + lane * 16;
    constexpr bool QREG = true;
    if constexpr (!QREG) {
#pragma unroll
        for (int d0 = 0; d0 < 8; ++d0) *(bf16x8*)(qb + d0 * 1024) = S.qr[d0]; }
    { constexpr int TN4 = (MODE == 0 ? TABD_N : TABB_N) / 4; const f32x4* tg = (const f32x4*)(P.tab + (size_t)cur.h * (MODE == 0 ? TABD_N : TABB_N));
      static_assert(TN4 <= 512, "one copy per thread"); if (tid < TN4) ((f32x4*)tabL)[tid] = tg[tid];
      __syncthreads(); }
    float farb = 0.f; const unsigned long long* mrow = nullptr; const float neginf = -__builtin_inff(); MaskT MK; unsigned mtouch = 0u; const unsigned lane4 = (unsigned)lane * 4u; (void)lane4;
    if constexpr (MODE == 1) { farb = P.farb[cur.h];
        mrow = P.mask + mask_off(cur.tok0 / SEQ, qlo >> 5); }
    float m_reg = -1e30f, l_reg = 0; f32x16 o[4] = {};
    const int sr = tid >> 4, sc = (tid & 15) * 8, vst0 = v_st(sr, sc), vst1 = v_st(32 + sr, sc), kws = KSWZ(sr, sc * 2);
    const int vb0 = (int)(uintptr_t)V_lds + v_rd_base(lane);
    const unsigned loff0 = (unsigned)(sr * P.tstep * 1024 + sc) * 2u, loff1 = loff0 + (unsigned)(32 * P.tstep) * 2048u;
#define RESC(a) do { if constexpr (false) if (__any((a) < 1.f)) { if (hi == 0) al_l[r32] = (a); asm volatile("s_waitcnt lgkmcnt(0)" ::: "memory");              \
                     for (int d_ = 0; d_ < 4; ++d_) for (int r = 0; r < 16; ++r) o[d_][r] *= (al_l + 4 * hi)[(r & 3) + 8 * (r >> 2)]; } } while (0)
#define KBASE(t) ((j_lo + (t)) * KVBLK)
#define ACT(t) (KBASE(t) <= qlo + QBLK - 1 && KBASE(t) + KVBLK - 1 >= qlo - W + 1)
    constexpr bool SK = (MODE == 0);
#define MASKT(P0_, P1_, t) do { const int kb_ = KBASE(t); \
        if constexpr (MODE == 0) { if (ACT(t)) { bias_tile(P0_, P1_, tabL, qm - kb_); \
                if (kb_ + KVBLK - 1 > qlo || kb_ <= qlo + QBLK - 1 - W) mask_tile(P0_, P1_, qm - kb_, (unsigned)W); } } \
        else { mask_wait(MK); if (FAR_T(t)) arg_tile_far(P0_, P1_, MK, neginf); else arg_tile_near(P0_, P1_, tabL, qm - kb_, MK, neginf); } } while (0)
  \
#define MTOUCH(t) do { if constexpr (MODE == 1) { if ((t) + 2 < NT) { const char* mp_ = (const char*)(mrow + (size_t)(j_lo + (t) + 2) * 32); \
        asm volatile("global_load_dword %0, %1, %2" : "+v"(mtouch) : "v"(lane4), "s"(mp_) : "memory"); } } } while (0)
#define MLOAD(t) do { if constexpr (MODE == 1) mask_issue(MK, mrow + (size_t)(j_lo + (t)) * 32); } while (0)
#define FAR_T(t) (MODE == 1 && qlo - (KBASE(t) + KVBLK - 1) >= FAR_DIST)
#define QINIT(t) (FAR_T(t) ? farb : 0.f)
#define PSM(P0_, P1_, mn_, al_) do { exp_half(P0_); } while (0)
#define FSM(P0_, P1_, al_) do { finishSM1(P0_, P1_, l_reg, pa0, pa1, pa2, pa3); } while (0)
    constexpr int NQL = 8;
#define SEAM_K0() do { VMWN(NQL); SWRITE_K(0); SBAR(); SLOAD_V(nxt, kbn); SBAR(); } while (0)
    f32x16 pA0, pA1, pB0, pB1; float mnA = 0.f, mnB = 0.f, alA = 1.f, alB = 1.f; bf16x8 pa0, pa1, pa2, pa3; (void)mnA; (void)mnB;
    int r0 = 0, r1 = SHM_V, r2 = LDS_Q;
#define VROT() do { const int r_ = r0; r0 = r1; r1 = r2; r2 = r_; } while (0)
    VMW(); SWRITE_VO(0); SBAR();
    if (NT > 1) { SLOAD_K(cur, KBASE(1)); }
    MLOAD(0); MTOUCH(-1); MTOUCH(0); SBAR(); qkt<0, SK, QREG>(pA0, pA1, K_lds, r32, hi, qb, S.qr, ACT(0), QINIT(0));
    if (NT > 1) { VMW(); SWRITE_K(1); SBAR(); SLOAD_V(cur, KBASE(1)); SBAR(); }
    MASKT(pA0, pA1, 0); PSM(pA0, pA1, mnA, alA);
    if (NT > 1) { VMW(); SWRITE_VO(SHM_V); SBAR(); if (NT > 2) SLOAD_K(cur, KBASE(2)); }
    __syncthreads();
#define HALF_STEP(PX0, PX1, mnX, alX, PY0, PY1, alY, t, KB, VB, SB) do {                                                      \
        SBAR(); qkt_fsm1<KB, SK>(PX0, PX1, K_lds, r32, hi, S.qr, QINIT(t), PY0, PY1, l_reg, pa0, pa1, pa2, pa3, ACT(t)); SBAR();   \
        if ((t) + 1 < NT) { VMW(); SWRITE_K(SB); SBAR(); SLOAD_V(cur, KBASE((t) + 1)); SBAR(); }                         \
        MLOAD(t); MTOUCH(t); SBAR();                                                                                   \
        pv_tile<0, SK>(o, vb0 + r0, pa0, pa1, pa2, pa3, ACT((t) - 1)); MASKT(PX0, PX1, (t)); PSM(PX0, PX1, mnX, alX);   \
        if ((t) + 1 < NT) { VMW(); SWRITE_VO(r2); SBAR(); if ((t) + 2 < NT) SLOAD_K(cur, KBASE((t) + 2)); }              \
        VROT();                                                                                                           \
        __syncthreads(); } while (0)
    for (int t = 1; t + 1 < NT; t += 2) {
        HALF_STEP(pB0, pB1, mnB, alB, pA0, pA1, alA, t, 1, 0, 0);
        HALF_STEP(pA0, pA1, mnA, alA, pB0, pB1, alB, t + 1, 0, 1, 1);
    }
    const bool even = (NT & 1) == 0;
    asm volatile("" :: "v"(mtouch));
    if (even) { SBAR(); qkt<1, SK, QREG>(pB0, pB1, K_lds, r32, hi, qb, S.qr, ACT(NT - 1), QINIT(NT - 1)); SBAR(); }
    SLOAD_K(nxt, kbn); SBAR();
    { const int tq_ = launder_v(tid_phase), r32q = tq_ & 31, hiq = (tq_ >> 5) & 1; const unsigned qoffq = (unsigned)(r32q * P.tstep * 1024 + hiq * 8) * 2u;
      const char* qp_ = UROW(P.Q, nxt, nxt.P0 + wid * QBLK);
#pragma unroll
      for (int d0 = 0; d0 < 8; ++d0) S.qr[d0] = *(const bf16x8*)(qp_ + qoffq + d0 * 32); }
    SBAR();
    if (even) MLOAD(NT - 1);
    FSM(pA0, pA1, alA); SBAR();
    pv_tile<0, SK>(o, vb0 + r0, pa0, pa1, pa2, pa3, ACT(even ? NT - 2 : NT - 1));
    if (even) { MASKT(pB0, pB1, NT - 1); PSM(pB0, pB1, mnB, alB); __syncthreads(); RESC(alB);
        FSM(pB0, pB1, alB); SBAR(); pv_tile<0, SK>(o, vb0 + r1, pa0, pa1, pa2, pa3, ACT(NT - 1)); }
    SBAR(); SEAM_K0();
    const int te_ = launder_v(tid_phase), r32e = te_ & 31, hie = (te_ >> 5) & 1;
    if constexpr (MODE == 1) {
        if (hie == 0) li_l[r32e] = l_reg; asm volatile("s_waitcnt lgkmcnt(0)" ::: "memory");
        const float* lih = li_l + 4 * hie;
        bf16_t* Ob = P.Out + ((size_t)(cur.tok0 + qlo + 4 * hie) * 2048 + 1024 + cur.h * 128 + r32e);
#pragma unroll
        for (int r = 0; r < 16; ++r) { const int cr = (r & 3) + 8 * (r >> 2); const float rl = __builtin_amdgcn_rcpf(lih[cr]);
#pragma unroll
            for (int d0 = 0; d0 < 4; ++d0) { const float v = o[d0][r] * rl; const float vn = lane_xor_f<1>(v);
                if ((r32e & 1) == 0) *(unsigned*)(Ob + (size_t)cr * 2048 + d0 * 32) = cvt_pk_bf16(v, vn); } }
    } else {
        float lf = l_reg;
        const int pass = P.pass, ts = P.tstep;
        if (hie == 0) { const size_t li = (size_t)(cur.tok0 + (qlo + r32e) * ts) * 8 + cur.h;
            if (pass == 0) P.Lacc[li] = lf; else if (pass == 1) P.Lacc2[li] = lf; else lf += P.Lacc[li] + P.Lacc2[li];
            li_l[r32e] = lf; }
        asm volatile("s_waitcnt lgkmcnt(0)" ::: "memory");
        const float* lih = li_l + 4 * hie;
        const size_t tokb = (size_t)(cur.tok0 + (qlo + 4 * hie) * ts);
        const size_t oofs = tokb * 1024 + cur.h * 128 + r32e;
        if (pass != 2) {
            bf16_t* Odst = (pass == 0 ? P.Oacc : P.Oacc2) + oofs;
#pragma unroll
            for (int r = 0; r < 16; ++r) { const int cr = (r & 3) + 8 * (r >> 2); bf16_t* Oa = Odst + (size_t)(cr * ts) * 1024;
#pragma unroll
                for (int d0 = 0; d0 < 4; ++d0) { const float v = o[d0][r]; const float vn = lane_xor_f<1>(v);
                    if ((r32e & 1) == 0) *(unsigned*)(Oa + d0 * 32) = cvt_pk_bf16(v, vn); } }
        } else {
            const int odd = r32e & 1;
            const bf16_t* Oab = P.Oacc + oofs - odd; const bf16_t* Obb = P.Oacc2 + oofs - odd; bf16_t* Owb = P.Out + tokb * 2048 + cur.h * 128 + r32e;
            unsigned pa_[16][4], pb_[16][4];
#pragma unroll
            for (int r = 0; r < 16; ++r) { const int cr = (r & 3) + 8 * (r >> 2); const size_t ro = (size_t)(cr * ts) * 1024;
#pragma unroll
                for (int d0 = 0; d0 < 4; ++d0) { pa_[r][d0] = *(const unsigned*)(Oab + ro + d0 * 32); pb_[r][d0] = *(const unsigned*)(Obb + ro + d0 * 32); } }
#pragma unroll
            for (int r = 0; r < 16; ++r) { const int cr = (r & 3) + 8 * (r >> 2); const float rl = __builtin_amdgcn_rcpf(lih[cr]); bf16_t* Ow = Owb + (size_t)(cr * ts) * 2048;
#pragma unroll
                for (int d0 = 0; d0 < 4; ++d0) { const float fa = __uint_as_float(odd ? (pa_[r][d0] & 0xffff0000u) : (pa_[r][d0] << 16)), fb = __uint_as_float(odd ? (pb_[r][d0] & 0xffff0000u) : (pb_[r][d0] << 16));
                    const float v = ((fa + fb) + o[d0][r]) * rl; const float vn = lane_xor_f<1>(v);
                    if ((r32e & 1) == 0) *(unsigned*)(Ow + d0 * 32) = cvt_pk_bf16(v, vn); } }
        }
    }
    __syncthreads();
#undef RESC
#undef KBASE
#undef ACT
#undef MASKT
#undef PSM
#undef FSM
#undef FAR_T
#undef MLOAD
#undef MTOUCH
#undef QINIT
#undef SEAM_K0
#undef HALF_STEP
#undef VROT
}
template <int MODE>
__device__ __forceinline__ bool get_blk(const PhaseP<MODE>& P, int n, int c, int G, Blk& b) {
    if constexpr (MODE == 0) {
        int L = c + n * G;
        if (G == 256) { if (n >= 4) return false; L = (2 * (c & 7) + (n >> 1)) * 64 + (c >> 3) + 32 * (n & 1); }
        if (L >= 1024) return false;
        const int bh = L >> 6, rem = L & 63, nqb = 64 / P.tstep, r = rem / nqb, qb = rem % nqb;
        b.tok0 = (bh >> 3) * SEQ + r; b.h = bh & 7; b.P0 = qb * QB; return true;
    } else {
        int it = c + (n >> 1) * G;
        if (G == 256) { if (n >= 4) return false; it = ((c & 7) + 8 * (n >> 1)) * 32 + (c >> 3); }
        if (it >= 512) return false;
        const int bh = it >> 5, x = it & 31;
        b.tok0 = (bh >> 3) * SEQ; b.h = bh & 7; b.P0 = ((n & 1) ? 63 - x : x) * QB; return true;
    }
}
template <int MODE>
__device__ __forceinline__ void attn_phase(const PhaseP<MODE>& P, char* lds, int c, int G, const int tid) {
    Blk cur, nxt; int n = 0;
    if (!get_blk<MODE>(P, 0, c, G, cur)) return;
    Seam S;
    attn_prime<MODE>(P, cur, lds, S, tid);
    for (;;) {
        const bool more = get_blk<MODE>(P, n + 1, c, G, nxt);
        if (!more) nxt = cur;
        attn_block<MODE>(P, cur, nxt, lds, S, tid);
        if (!more) break;
        cur = nxt; ++n;
    }
    VMW(); __syncthreads();
}
#undef AROW
#undef VMW
#undef VMWN
#undef SLOAD_K
#undef UROW
#undef QLOAD
#undef LANE_OFFS
#undef SLOAD_V
#undef SWRITE_K
#undef SWRITE_V
}

namespace idx {
constexpr int CAP = 448, CHUNK = 128;
constexpr int LDS_KBUF = 0;
constexpr int LDS_CAND = 32768;
constexpr int LDS_BITS = 32768;
constexpr int IDX_LDS = LDS_CAND + 32 * CAP * 8;
constexpr float IDX_SCALE = 0.03125f;
__device__ __forceinline__ unsigned fkey(float f) { const unsigned b = __float_as_uint(f); return b ^ ((unsigned)((int)b >> 31) | 0x80000000u); }
__device__ __forceinline__ float fkey_inv(unsigned k) { return __uint_as_float((k & 0x80000000u) ? (k ^ 0x80000000u) : ~k); }
typedef unsigned long long u64;
__device__ __forceinline__ int count_ge(const u64 (&e)[7], u64 mid) {
    int c = 0;
#pragma unroll
    for (int j = 0; j < 7; ++j) c += __popcll(__ballot(e[j] >= mid));
    return c;
}
__device__ __forceinline__ u64 bisect(const u64 (&e)[7], u64 lo, int ksel, int thi) {
    unsigned mk = 0;
#pragma unroll
    for (int j = 0; j < 7; ++j) { const unsigned k = (unsigned)(e[j] >> 32); mk = k > mk ? k : mk; }
    mk = (unsigned)__builtin_amdgcn_readfirstlane((int)wave_max_u(mk));
    u64 hi = ((u64)mk << 32) | 0xffffffffull;
    for (int it = 0; it < 80; ++it) {
        if (hi - lo <= 1ull) break;
        const u64 mid = lo + ((hi - lo) >> 1);
        const int c = count_ge(e, mid);
        if (c >= ksel) { lo = mid; if (c <= thi) break; } else hi = mid;
    }
    return lo;
}
__device__ __forceinline__ int count_ge32(const unsigned (&k)[7], unsigned mid) {
    int c = 0;
#pragma unroll
    for (int j = 0; j < 7; ++j) c += __popcll(__builtin_amdgcn_uicmp(k[j], mid, 35  ));
    return c;
}
template <int Q>
__device__ __forceinline__ void compact(char* cand, int wid, int lane, int (&cnt)[4], float (&thr)[4], const int ksel) {
    u64* base = (u64*)(cand + (size_t)(4 * wid + Q) * CAP * 8);
    const int n = cnt[Q];
    u64 e[7]; unsigned k[7];
#pragma unroll
    for (int j = 0; j < 7; ++j) { const int i = lane + 64 * j; e[j] = (i < n) ? base[i] : 0ull; k[j] = (unsigned)(e[j] >> 32); }
    unsigned mk = 0;
#pragma unroll
    for (int j = 0; j < 7; ++j) mk = k[j] > mk ? k[j] : mk;
    unsigned hi = (unsigned)__builtin_amdgcn_readfirstlane((int)wave_max_u(mk));
    unsigned lo = (unsigned)__builtin_amdgcn_readfirstlane((int)fkey(thr[Q]));
    for (int it = 0; it < 40; ++it) {
        if (hi - lo <= 1u) break;
        const unsigned mid = lo + ((hi - lo) >> 1);
        const int c = count_ge32(k, mid);
        if (c >= ksel) { lo = mid; if (c <= ksel + 64) break; } else hi = mid;
    }
    int pos = 0;
#pragma unroll
    for (int j = 0; j < 7; ++j) { const u64 mkk = __builtin_amdgcn_uicmp(k[j], lo, 35);
        const int pre = __builtin_amdgcn_mbcnt_hi((unsigned)(mkk >> 32), __builtin_amdgcn_mbcnt_lo((unsigned)mkk, 0));
        if (k[j] >= lo) base[pos + pre] = e[j];
        pos += __popcll(mkk); }
    cnt[Q] = pos; thr[Q] = fkey_inv(lo);
    if (pos > CAP - 32) {
#pragma unroll
        for (int j = 0; j < 7; ++j) { const int i = lane + 64 * j; e[j] = (i < pos) ? base[i] : 0ull; }
        const u64 T = bisect(e, (u64)lo << 32, ksel, ksel + 32);
        int p2 = 0;
#pragma unroll
        for (int j = 0; j < 7; ++j) { const bool keep = e[j] >= T; const u64 mk2 = __ballot(keep);
            const int pre = __builtin_amdgcn_mbcnt_hi((unsigned)(mk2 >> 32), __builtin_amdgcn_mbcnt_lo((unsigned)mk2, 0));
            if (keep) base[p2 + pre] = e[j];
            p2 += __popcll(mk2); }
        cnt[Q] = p2; thr[Q] = fkey_inv((unsigned)(T >> 32));
    }
}
template <int Q>
__device__ __forceinline__ void final_select(char* cand, int wid, int lane, const int (&cnt)[4], const float (&thr)[4], unsigned (&sel)[4][7]) {
    const u64* base = (const u64*)(cand + (size_t)(4 * wid + Q) * CAP * 8);
    const int n = cnt[Q];
    u64 e[7];
#pragma unroll
    for (int j = 0; j < 7; ++j) { const int i = lane + 64 * j; e[j] = (i < n) ? base[i] : 0ull; }
    u64 T = 1ull;
    if (n > TOPK) T = bisect(e, (u64)fkey(thr[Q]) << 32, TOPK, TOPK);
#pragma unroll
    for (int j = 0; j < 7; ++j) sel[Q][j] = (e[j] >= T) ? ~(unsigned)e[j] : 0xffffffffu;
}

template <int Q>
__device__ __forceinline__ float kth_value(char* cand, int wid, int lane, const int (&cnt)[4], const float (&thr)[4], const int ksel) {
    const u64* base = (const u64*)(cand + (size_t)(4 * wid + Q) * CAP * 8);
    const int n = cnt[Q];
    if (n < ksel) return -__builtin_inff();
    u64 e[7];
#pragma unroll
    for (int j = 0; j < 7; ++j) { const int i = lane + 64 * j; e[j] = (i < n) ? base[i] : 0ull; }
    const u64 T = bisect(e, (u64)fkey(thr[Q]) << 32, ksel, ksel);
    return fkey_inv((unsigned)(T >> 32));
}
struct IdxP { const bf16_t* QI; const bf16_t* KI; const bf16_t* WI; unsigned long long* mask; };
__device__ __forceinline__ void idx_item(const IdxP& P, char* lds, int b, int t0, const int tid) {
    const int wid = __builtin_amdgcn_readfirstlane(tid >> 6), lane = tid & 63, c = lane & 31, hi = lane >> 5;
    char* kbuf = lds + LDS_KBUF; char* cand = lds + LDS_CAND;
    const int tq0 = t0 + 4 * wid;
    const size_t brow = (size_t)b * SEQ;
    bf16x8 a[2][4]; float w[2][16];
#pragma unroll
    for (int p = 0; p < 2; ++p) {
        const bf16_t* qp = P.QI + (brow + tq0 + 2 * p + ((c >> 2) & 1)) * 1024 + ((c >> 3) * 4 + (c & 3)) * 64 + 8 * hi;
#pragma unroll
        for (int ks = 0; ks < 4; ++ks) a[p][ks] = *(const bf16x8*)(qp + 16 * ks);
        const u32x4* wp = (const u32x4*)(P.WI + (brow + tq0 + 2 * p + hi) * 16);
#pragma unroll
        for (int i8 = 0; i8 < 2; ++i8) { const u32x4 v = wp[i8];
#pragma unroll
            for (int i = 0; i < 4; ++i) { w[p][8 * i8 + 2 * i] = bf_lo(v[i]) * IDX_SCALE; w[p][8 * i8 + 2 * i + 1] = bf_hi(v[i]) * IDX_SCALE; } }
    }
#pragma unroll
    for (int p = 0; p < 2; ++p) {
#pragma unroll
        for (int ks = 0; ks < 4; ++ks) asm volatile("" :: "v"(a[p][ks]));
#pragma unroll
        for (int i = 0; i < 16; ++i) asm volatile("" :: "v"(w[p][i]));
    }
    int cnt[4] = {0, 0, 0, 0}; float thr[4];
#pragma unroll
    for (int q = 0; q < 4; ++q) thr[q] = -__builtin_inff();
    const int nch = (t0 + 32 + CHUNK - 1) / CHUNK;
    const int pr0 = tid >> 3, pc0 = tid & 7, pr1 = pr0 + 64;
    const int wo0 = pr0 * 128 + ((pc0 ^ ((pr0 >> 1) & 7)) << 4), wo1 = pr1 * 128 + ((pc0 ^ ((pr1 >> 1) & 7)) << 4);
    const bf16_t* kg = P.KI + brow * 64 + (size_t)pr0 * 64 + pc0 * 8;
    bf16x8 s0, s1;
#define IDX_BF(dst, tl_) do { const int row_ = (tl_) * 32 + c; const char* rp_ = kb + row_ * 128; const int sw_ = (row_ >> 1) & 7; \
        _Pragma("unroll") for (int ks = 0; ks < 4; ++ks) dst[ks] = *(const bf16x8*)(rp_ + (((2 * ks + hi) ^ sw_) << 4)); } while (0)
#define IDX_MMA(accv, p_, bfv) do { asm volatile("v_mfma_f32_32x32x16_bf16 %0, %1, %2, 0" : "=&v"(accv) : "v"(a[p_][0]), "v"(bfv[0])); \
        _Pragma("unroll") for (int ks = 1; ks < 4; ++ks) asm volatile("v_mfma_f32_32x32x16_bf16 %0, %1, %2, %0" : "+v"(accv) : "v"(a[p_][ks]), "v"(bfv[ks])); \
        __builtin_amdgcn_sched_barrier(0); } while (0)
#define IDX_SEL(accv, p_, tl_) do { float sc = 0.f; \
        _Pragma("unroll") for (int i = 0; i < 16; ++i) sc = fmaf(w[p_][i], __int_as_float(max(__float_as_int(accv[i]), 0)), sc); \
        const int kb32_ = ch * CHUNK + (tl_) * 32; \
        const u64 m = __builtin_amdgcn_fcmpf(sc, thrv[p_], 3  ) & __builtin_amdgcn_sicmp(kb32_, tc[p_], 41  ); \
        if (m) { \
            const bool pass = (sc >= thrv[p_]) && (kb32_ <= tc[p_]); \
            const unsigned mlo = (unsigned)m, mhi = (unsigned)(m >> 32); \
            const int nlo = __popc(mlo), nhi = __popc(mhi); \
              \
              \
            const int tsel_ = hi ? (cnt[2 * (p_) + 1] - nlo) : cnt[2 * (p_)]; \
            const int slot = __builtin_amdgcn_mbcnt_hi(mhi, __builtin_amdgcn_mbcnt_lo(mlo, tsel_)); \
            if (pass) { u32x2 ent; ent.x = (unsigned)(~kb32_) - (unsigned)c; ent.y = fkey(sc + 0.0f); *(u32x2*)(cbl + (2 * (p_)) * CAP * 8 + slot * 8) = ent; } \
            cnt[2 * (p_)] += nlo; cnt[2 * (p_) + 1] += nhi; \
            if (cnt[2 * (p_)] > CAP - 32) { compact<2 * (p_)>(cand, wid, lane, cnt, thr, ksel); thrv[p_] = hi ? thr[2 * (p_) + 1] : thr[2 * (p_)]; } \
            if (cnt[2 * (p_) + 1] > CAP - 32) { compact<2 * (p_) + 1>(cand, wid, lane, cnt, thr, ksel); thrv[p_] = hi ? thr[2 * (p_) + 1] : thr[2 * (p_)]; } \
        } } while (0)
    float thrv[2] = {-__builtin_inff(), -__builtin_inff()};
    char* const cbl = cand + (size_t)(4 * wid + hi) * CAP * 8;
    const int tc[2] = {tq0 + hi - c, tq0 + 2 + hi - c};
#ifndef IDX_FORCE_REDO
#define IDX_FORCE_REDO 0
#endif
    const bool can_pre = nch >= 32;
    const int nsamp = can_pre ? (nch - 8) / 16 + 1 : 0;
    const float fs = can_pre ? (float)nsamp / (float)nch : 0.f;
    int ksamp = can_pre ? (int)(255.f * fs + 6.0f * sqrtf(255.f * fs * (1.f - fs)) + 2.f) : 0;
    unsigned* flag = (unsigned*)(lds + IDX_LDS);
    for (int attempt = 0; attempt < 2; ++attempt) {
        const bool pre = can_pre && attempt == 0;
        for (int pass = pre ? 0 : 1; pass < 2; ++pass) {
            const int ksel = pass == 0 ? ksamp : TOPK;
            const int first = pass == 0 ? 7 : 0, step = pass == 0 ? 16 : 1;
            if (pass == 0 || !pre) {
#pragma unroll
                for (int q = 0; q < 4; ++q) { cnt[q] = 0; thr[q] = -__builtin_inff(); } }
            thrv[0] = hi ? thr[1] : thr[0]; thrv[1] = hi ? thr[3] : thr[2];
            { const bf16_t* kn = kg + (size_t)first * CHUNK * 64; s0 = *(const bf16x8*)kn; s1 = *(const bf16x8*)(kn + 64 * 64); }
            *(bf16x8*)(kbuf + wo0) = s0; *(bf16x8*)(kbuf + wo1) = s1;
            __syncthreads();
            int it = 0;
            for (int ch = first; ch < nch; ch += step, ++it) {
                const bool more = ch + step < nch;
                if (more) { const bf16_t* kn = kg + (size_t)(ch + step) * CHUNK * 64; s0 = *(const bf16x8*)kn; s1 = *(const bf16x8*)(kn + 64 * 64); }
                const char* kb = kbuf + (it & 1) * 16384;
                bf16x8 bfA[4], bfB[4]; f32x16 accA, accB;
                IDX_BF(bfA, 0); IDX_BF(bfB, 1);
                IDX_MMA(accA, 0, bfA);
                IDX_MMA(accB, 1, bfA); IDX_SEL(accA, 0, 0);
                IDX_MMA(accA, 0, bfB); IDX_SEL(accB, 1, 0); IDX_BF(bfA, 2);
                IDX_MMA(accB, 1, bfB); IDX_SEL(accA, 0, 1);
                IDX_MMA(accA, 0, bfA); IDX_SEL(accB, 1, 1); IDX_BF(bfB, 3);
                IDX_MMA(accB, 1, bfA); IDX_SEL(accA, 0, 2);
                IDX_MMA(accA, 0, bfB); IDX_SEL(accB, 1, 2);
                IDX_MMA(accB, 1, bfB); IDX_SEL(accA, 0, 3);
                IDX_SEL(accB, 1, 3);
                if (more) { char* kw = kbuf + ((it + 1) & 1) * 16384; *(bf16x8*)(kw + wo0) = s0; *(bf16x8*)(kw + wo1) = s1; }
                __syncthreads();
            }
            if (pass == 0) {
                const float v0 = kth_value<0>(cand, wid, lane, cnt, thr, ksel), v1 = kth_value<1>(cand, wid, lane, cnt, thr, ksel);
                const float v2 = kth_value<2>(cand, wid, lane, cnt, thr, ksel), v3 = kth_value<3>(cand, wid, lane, cnt, thr, ksel);
                thr[0] = v0; thr[1] = v1; thr[2] = v2; thr[3] = v3;
#pragma unroll
                for (int q = 0; q < 4; ++q) cnt[q] = 0;
            }
        }
        if (!pre) break;
        bool ok = true;
#pragma unroll
        for (int q = 0; q < 4; ++q) { const int need = (tq0 + q + 1) < TOPK ? (tq0 + q + 1) : TOPK; ok = ok && (cnt[q] >= need); }
        if (IDX_FORCE_REDO && ((t0 >> 5) % 5) == 0) ok = false;
        __syncthreads(); if (tid == 0) *flag = 0u; __syncthreads();
        if (!ok && lane == 0) *flag = 1u;
        __syncthreads(); const unsigned redo = *flag; __syncthreads();
        if (!redo) break;
    }
#undef IDX_BF
#undef IDX_MMA
#undef IDX_SEL
    unsigned sel[4][7];
    final_select<0>(cand, wid, lane, cnt, thr, sel); final_select<1>(cand, wid, lane, cnt, thr, sel);
    final_select<2>(cand, wid, lane, cnt, thr, sel); final_select<3>(cand, wid, lane, cnt, thr, sel);
    __syncthreads();
    unsigned* bits = (unsigned*)(lds + LDS_BITS);
    for (int i = tid; i < 65536 / 16; i += 512) ((u32x4*)bits)[i] = (u32x4){0u, 0u, 0u, 0u};
    __syncthreads();
#pragma unroll
    for (int q = 0; q < 4; ++q)
#pragma unroll
        for (int j = 0; j < 7; ++j) { const unsigned s = sel[q][j];
            if (s != 0xffffffffu) { const unsigned kk = s & 31u, r_ = ((kk >> 3) << 2) | (kk & 3u), hl = (kk >> 2) & 1u, half = (s >> 5) & 1u;
                atomicOr(&bits[((((s >> 6) * 32) + half * 16 + r_) << 1) + hl], 1u << (4 * wid + q)); } }
    __syncthreads();
    const int nb16 = (((t0 >> 8) * 4 + 3) + 1) * 256 / 16;
    u32x4* mo = (u32x4*)(P.mask + mask_off(b, t0 >> 5));
    for (int i = tid; i < nb16; i += 512) mo[i] = ((const u32x4*)bits)[i];
    __syncthreads();
}
__device__ __forceinline__ void idx_phase(const IdxP& P, char* lds, int c, int G, const int tid) {
    for (int i = c; i < 1024; i += G) { const int r = i >> 8, u = i & 255; idx_item(P, lds, r >> 1, ((r & 1) ? 511 - u : u) * 32, tid); }
}
}

struct CvItem { const float* W; const float* gk; bf16_t* WT; int N, K, k0, n0, row0; };
__device__ __forceinline__ void cv_load(const CvItem& I, int lane, f32x4 (&v)[8], float (&g)[8]) {
    const int kr = lane >> 3, c4 = 4 * (lane & 7); const bool ok = I.n0 + c4 < I.N;
    const float* p = I.W + (size_t)(I.k0 + kr) * I.N + I.n0 + c4;
#pragma unroll
    for (int i = 0; i < 8; ++i) v[i] = ok ? *(const f32x4*)(p + (size_t)(8 * i) * I.N) : (f32x4){0.f, 0.f, 0.f, 0.f};
    if (I.gk) {
#pragma unroll
        for (int i = 0; i < 8; ++i) g[i] = I.gk[I.k0 + 8 * i + kr];
    } else {
#pragma unroll
        for (int i = 0; i < 8; ++i) g[i] = 1.0f;
    }
}
__device__ __forceinline__ void cv_emit(const CvItem& I, float* scr, int lane, const f32x4 (&v)[8], const float (&g)[8]) {
    { float* d = scr + (lane >> 3) * 33 + 4 * (lane & 7);
#pragma unroll
      for (int i = 0; i < 8; ++i) { d[i * 8 * 33 + 0] = v[i][0] * g[i]; d[i * 8 * 33 + 1] = v[i][1] * g[i]; d[i * 8 * 33 + 2] = v[i][2] * g[i]; d[i * 8 * 33 + 3] = v[i][3] * g[i]; } }
    LDS_WAIT(); asm volatile("" ::: "memory");
    const int cc = lane & 7;
#pragma unroll
    for (int j = 0; j < 4; ++j) { const int n = (lane >> 3) + 8 * j; const float* s = scr + (8 * cc) * 33 + n;
        u32x4 o; o.x = cvt_pk_bf16(s[0 * 33], s[1 * 33]); o.y = cvt_pk_bf16(s[2 * 33], s[3 * 33]); o.z = cvt_pk_bf16(s[4 * 33], s[5 * 33]); o.w = cvt_pk_bf16(s[6 * 33], s[7 * 33]);
        if (I.n0 + n < I.N) *(u32x4*)(I.WT + (size_t)(I.row0 + n) * I.K + I.k0 + 8 * cc) = o; }
    LDS_WAIT(); asm volatile("" ::: "memory");
}
struct ConvP { const float* w1i; const float* w1o; const float* win; const float* wout; const float* w2i; const float* w2o; const float* g1; const float* gm; const float* g2; unsigned char* ws; };
__device__ __forceinline__ int swiglu_row(int n0) { const int up = n0 >= DFF ? 1 : 0, j = n0 - up * DFF; return 256 * (j >> 7) + 128 * up + (j & 127); }
__device__ __forceinline__ void convert_phase(const ConvP& P, char* lds, int gw, int NGW, int wave, int lane) {
    float* scr = (float*)(lds + wave * 16384);
    constexpr int I_UP = (DM / 64) * (2 * DFF / 32), I_DN = (DFF / 64) * (DM / 32), I_IN = (DM / 64) * ((PROJW + 31) / 32), I_OUT = (DM / 64) * (DM / 32);
    constexpr int NITEMS = 2 * I_UP + 2 * I_DN + I_IN + I_OUT;
    auto decode = [&](int r) -> CvItem {
        CvItem I;
        if (r < 2 * I_UP) { const bool s = r >= I_UP; r -= s ? I_UP : 0; const int nb = 2 * DFF / 32, kb = r / nb, n0 = (r % nb) * 32;
            I.W = s ? P.w2i : P.w1i; I.gk = s ? P.g2 : P.g1; I.WT = (bf16_t*)(P.ws + (s ? WS_W2I : WS_W1I)); I.N = 2 * DFF; I.K = DM; I.k0 = kb * 64; I.n0 = n0; I.row0 = swiglu_row(n0); return I; }
        r -= 2 * I_UP;
        if (r < 2 * I_DN) { const bool s = r >= I_DN; r -= s ? I_DN : 0; const int nb = DM / 32, kb = r / nb, n0 = (r % nb) * 32;
            I.W = s ? P.w2o : P.w1o; I.gk = nullptr; I.WT = (bf16_t*)(P.ws + (s ? WS_W2O : WS_W1O)); I.N = DM; I.K = DFF; I.k0 = kb * 64; I.n0 = n0; I.row0 = n0; return I; }
        r -= 2 * I_DN;
        if (r < I_IN) { const int nb = (PROJW + 31) / 32, kb = r / nb, n0 = (r % nb) * 32;
            I.W = P.win; I.gk = P.gm; I.WT = (bf16_t*)(P.ws + WS_WIN); I.N = PROJW; I.K = DM; I.k0 = kb * 64; I.n0 = n0; I.row0 = n0; return I; }
        r -= I_IN;
        { const int nb = DM / 32, kb = r / nb, n0 = (r % nb) * 32;
            I.W = P.wout; I.gk = nullptr; I.WT = (bf16_t*)(P.ws + WS_WOUT); I.N = DM; I.K = DM; I.k0 = kb * 64; I.n0 = n0; I.row0 = n0; return I; }
    };
    {
        f32x4 va[8], vb[8]; float ga[8], gb[8];
        int it = gw; CvItem ia{}, ib{};
        if (it < NITEMS) { ia = decode(it); cv_load(ia, lane, va, ga); }
        if (it + NGW < NITEMS) { ib = decode(it + NGW); cv_load(ib, lane, vb, gb); }
        while (it < NITEMS) {
            { const CvItem cur = ia; cv_emit(cur, scr, lane, va, ga); if (it + 2 * NGW < NITEMS) { ia = decode(it + 2 * NGW); cv_load(ia, lane, va, ga); } }
            it += NGW; if (it >= NITEMS) break;
            { const CvItem cur = ib; cv_emit(cur, scr, lane, vb, gb); if (it + 2 * NGW < NITEMS) { ib = decode(it + 2 * NGW); cv_load(ib, lane, vb, gb); } }
            it += NGW;
        }
    }
    { u32x4* z = (u32x4*)((bf16_t*)(P.ws + WS_WIN) + (size_t)PROJW * DM); const int n16 = (PROJP - PROJW) * DM * 2 / 16;
      for (int i = gw * 64 + lane; i < n16; i += NGW * 64) z[i] = (u32x4){0u, 0u, 0u, 0u}; }
}
__device__ __forceinline__ int rel_bucket(int d) {
    if (d < 16) return d;
    const int th[15] = {22, 30, 40, 54, 73, 99, 134, 182, 246, 332, 450, 609, 825, 1117, 1513};
    int b = 16;
#pragma unroll
    for (int i = 0; i < 15; ++i) b += (d >= th[i]) ? 1 : 0;
    return b;
}
__device__ __forceinline__ void table_phase(const float* rel_bias, unsigned char* ws, int gtid, int gstride) {
    float* tabd = (float*)(ws + WS_TABD); float* tabb = (float*)(ws + WS_TABB); float* farb = tabb + 8 * TABB_N;
    const float inv = 1.0f / SCALE;
    for (int i = gtid; i < 3 * 8 * TABD_N; i += gstride) { const int br = i / (8 * TABD_N), h = (i / TABD_N) & 7, step = i % TABD_N - TAB_OFF; const int dil = br == 0 ? 1 : (br == 1 ? 4 : 16);
        tabd[i] = (step >= 0 && step <= 128) ? rel_bias[rel_bucket(step * dil) * 16 + h] * LOG2E : 0.f; }
    for (int i = gtid; i < 8 * TABB_N; i += gstride) { const int h = i / TABB_N, d = i % TABB_N - TAB_OFF;
        tabb[i] = d >= 0 ? rel_bias[rel_bucket(d) * 16 + 8 + h] * LOG2E : 0.f; }
    for (int i = gtid; i < 8; i += gstride) farb[i] = rel_bias[31 * 16 + 8 + i] * LOG2E;
}
__device__ __forceinline__ void xb_phase(const float* x, bf16_t* out, unsigned* ss, int gw, int NGW, int lane) {
    for (int m = gw; m < MROWS; m += NGW) {
        const f32x4* xr = (const f32x4*)(x + (size_t)m * DM) + lane;
        f32x4 v[8]; float s = 0.f;
#pragma unroll
        for (int j = 0; j < 8; ++j) { v[j] = xr[64 * j]; s += (v[j][0] * v[j][0] + v[j][1] * v[j][1]) + (v[j][2] * v[j][2] + v[j][3] * v[j][3]); }
        s = wave_sum(s);
        if (lane == 0) ss[m] = (unsigned)(s * SS_SCALE + 0.5f);
        u32x2* o = (u32x2*)(out + (size_t)m * DM) + lane;
#pragma unroll
        for (int j = 0; j < 8; ++j) { u32x2 wv; wv.x = cvt_pk_bf16(v[j][0], v[j][1]); wv.y = cvt_pk_bf16(v[j][2], v[j][3]); o[64 * j] = wv; }
    }
}
__device__ __forceinline__ void qknorm_phase(unsigned char* ws, const float* gqa, const float* gka, const float* gqb, const float* gkb, int gw, int NGW, int lane) {
    { const bf16_t* t7 = (const bf16_t*)(ws + WS_QA) + 7 * TSTRIDE; bf16_t* kic = (bf16_t*)(ws + WS_KIC); bf16_t* wic = (bf16_t*)(ws + WS_WIC);
      for (int m = gw; m < MROWS; m += NGW) { if (lane < 10) { const u32x4 v = *(const u32x4*)(t7 + (size_t)m * 1024 + lane * 8);
              if (lane < 8) *(u32x4*)(kic + (size_t)m * 64 + lane * 8) = v; else *(u32x4*)(wic + (size_t)m * 16 + (lane - 8) * 8) = v; } } }
    for (int it = gw; it < 4 * MROWS; it += NGW) {
        const int t = it / MROWS, m = it % MROWS;
        const int tsel = t == 0 ? 0 : (t == 1 ? 1 : (t == 2 ? 3 : 4));
        const float* g = t == 0 ? gqa : (t == 1 ? gka : (t == 2 ? gqb : gkb));
        bf16_t* row = (bf16_t*)(ws + WS_QA) + (size_t)tsel * TSTRIDE + (size_t)m * 1024 + lane * 16;
        u32x4 r0 = *(u32x4*)row, r1 = *(u32x4*)(row + 8);
        float v[16];
#pragma unroll
        for (int i = 0; i < 4; ++i) { v[2 * i] = bf_lo(r0[i]); v[2 * i + 1] = bf_hi(r0[i]); v[8 + 2 * i] = bf_lo(r1[i]); v[8 + 2 * i + 1] = bf_hi(r1[i]); }
        float s = 0.f;
#pragma unroll
        for (int i = 0; i < 16; ++i) s += v[i] * v[i];
        s += lane_xor_f<1>(s); s += lane_xor_f<2>(s); s += lane_xor_f<4>(s);
        const float rstd = 1.0f / sqrtf(s * (1.0f / HD) + EPS);
        const float* gp = g + (lane & 7) * 16; const float rs = (t == 2) ? rstd * (SCALE * LOG2E) : rstd;
#pragma unroll
        for (int i = 0; i < 16; ++i) v[i] = v[i] * rs * gp[i];
#pragma unroll
        for (int i = 0; i < 4; ++i) { r0[i] = cvt_pk_bf16(v[2 * i], v[2 * i + 1]); r1[i] = cvt_pk_bf16(v[8 + 2 * i], v[8 + 2 * i + 1]); }
        *(u32x4*)row = r0; *(u32x4*)(row + 8) = r1;
    }
}

constexpr int NPH = 13;
struct Args { const float* in[15]; float* out; unsigned char* ws; int ph_lo, ph_hi; };
typedef const Args __attribute__((address_space(4)))* KArgP;
__device__ __forceinline__ KArgP kargs() { KArgP p = (KArgP)__builtin_amdgcn_kernarg_segment_ptr(); asm volatile("" : "+s"(p)); return p; }
#ifndef PHMASK
#define PHMASK 0xFFFF
#endif
#ifndef REPMASK
#define REPMASK 0
#endif
#define REP(k) for (int rep_ = 0; rep_ < (((REPMASK >> (k)) & 1) ? 2 : 1); ++rep_)
#define IN(k) (((PHMASK >> (k)) & 1) && lo <= base + (k) && base + (k) < hi)
#define SEAM(k) do { if (lo <= base + (k) && base + (k) + 1 < hi) { XcdBarrier bar_; bar_.bar = (unsigned*)(kargs()->ws + WS_CTL) + 1024; bar_.x = xb_xcc_id(); bar_.st = misc + 8; xcd_barrier(bar_); } } while (0)
#define GEOM() const int G = gridDim.x, bx = blockIdx.x; const int tid_ = phase_tid(wave0), lane = tid_ & 63, wave = __builtin_amdgcn_readfirstlane(tid_ >> 6); \
               const int vcu = (G % 8 == 0) ? (bx % 8) * (G / 8) + bx / 8 : bx; const int gw = vcu * 8 + wave, NGW = G * 8; (void)lane; (void)gw; (void)NGW
template <int L>
__device__ __forceinline__ void run_layer(const int lo, const int hi, const int wave0, char* lds, LAS unsigned char* lds_las, volatile LAS unsigned* misc) {
    constexpr int l = L, base = L * NPH;
#define SSP(ws_, k) ((unsigned*)((ws_) + WS_SS) + (size_t)(k) * MROWS)
    if (IN(0)) REP(0) { GEOM(); KArgP ka = kargs(); unsigned char* ws = ka->ws;
        ConvP cp; cp.w1i = ka->in[3] + (size_t)l * DM * 2 * DFF; cp.w1o = ka->in[4] + (size_t)l * DFF * DM; cp.win = ka->in[6] + (size_t)l * DM * PROJW;
        cp.wout = ka->in[11] + (size_t)l * DM * DM; cp.w2i = ka->in[13] + (size_t)l * DM * 2 * DFF; cp.w2o = ka->in[14] + (size_t)l * DFF * DM;
        cp.g1 = ka->in[2] + (size_t)l * DM; cp.gm = ka->in[5] + (size_t)l * DM; cp.g2 = ka->in[12] + (size_t)l * DM; cp.ws = ws;
        convert_phase(cp, lds, gw, NGW, wave, lane);
        if (l == 0) { table_phase(ka->in[1], ws, bx * 512 + tid_, G * 512); xb_phase(ka->in[0], (bf16_t*)(ws + WS_H), SSP(ws, 0), gw, NGW, lane); } }
    SEAM(0);
    if (IN(1)) REP(1) { KArgP ka = kargs(); unsigned char* ws = ka->ws; pg8::Gemm g{(const bf16_t*)(ws + WS_H), (const bf16_t*)(ws + WS_W1I), MROWS, 2 * DFF, DM}; pg8::StaticOrder S; S.init(MROWS, 2 * DFF, gridDim.x, blockIdx.x);
        pg8::EpiSwiglu E{(bf16_t*)(ws + WS_MID), DFF, SSP(ws, 3 * l)}; pg8::gemm_phase<pg8::EpiSwiglu, pg8::StaticOrder, true, true>(lds_las, g, S, E, phase_tid(wave0)); }
    SEAM(1);
    if (IN(2)) { KArgP ka = kargs(); unsigned char* ws = ka->ws; pg8::Gemm g{(const bf16_t*)(ws + WS_MID), (const bf16_t*)(ws + WS_W1O), MROWS, DM, DFF}; pg8::StaticOrder S; S.init(MROWS, DM, gridDim.x, blockIdx.x);
        pg8::EpiResid<true> E{l == 0 ? ka->in[0] : ka->out, ka->out, DM, 0.5f, (bf16_t*)(ws + WS_H), SSP(ws, 3 * l + 1)}; pg8::gemm_phase<pg8::EpiResid<true>, pg8::StaticOrder, true, true>(lds_las, g, S, E, phase_tid(wave0)); }
    SEAM(2);
    if (IN(3)) REP(3) { KArgP ka = kargs(); unsigned char* ws = ka->ws; pg8::Gemm g{(const bf16_t*)(ws + WS_H), (const bf16_t*)(ws + WS_WIN), MROWS, PROJP, DM}; pg8::StaticOrder S; S.init(MROWS, PROJP, gridDim.x, blockIdx.x);
        LAS float* X = (LAS float*)(lds_las + 131072);
        { const int t_ = phase_tid(wave0); X[2048 + t_] = (t_ < 128 ? ka->in[7] : (t_ < 256 ? ka->in[8] : (t_ < 384 ? ka->in[9] : ka->in[10])))[l * HD + (t_ & 127)]; __syncthreads(); }
        pg8::EpiProj E{(bf16_t*)(ws + WS_QA), SSP(ws, 3 * l + 1), (bf16_t*)(ws + WS_KIC), (bf16_t*)(ws + WS_WIC), X};
        pg8::gemm_phase<pg8::EpiProj, pg8::StaticOrder, true, true>(lds_las, g, S, E, phase_tid(wave0)); }
    SEAM(3);
    if (IN(5)) REP(5) { KArgP ka = kargs(); unsigned char* ws = ka->ws; bf16_t* T0 = (bf16_t*)(ws + WS_QA);
        idx::IdxP P{T0 + 6 * TSTRIDE, (const bf16_t*)(ws + WS_KIC), (const bf16_t*)(ws + WS_WIC), (unsigned long long*)(ws + WS_MASK) + (size_t)l * 2 * MASK_B}; idx::idx_phase(P, lds, blockIdx.x, gridDim.x, phase_tid(wave0)); }
#define DIL_PHASE(br) do { if (IN(6 + (br))) REP(6 + (br)) { KArgP ka = kargs(); unsigned char* ws = ka->ws; bf16_t* T0 = (bf16_t*)(ws + WS_QA); \
        att::PhaseP<0> P; P.Q = T0; P.K = T0 + TSTRIDE; P.V = T0 + 2 * TSTRIDE; P.tstep = (br) == 0 ? 1 : ((br) == 1 ? 4 : 16); P.skv = SEQ / P.tstep; P.W = 129; \
        P.tab = (const float*)(ws + WS_TABD) + (br) * 8 * TABD_N; P.Oacc = (bf16_t*)(ws + WS_OACC); P.Lacc = (float*)(ws + WS_LACC); P.Oacc2 = (bf16_t*)(ws + WS_OACC2); P.Lacc2 = (float*)(ws + WS_LACC2); P.Out = (bf16_t*)(ws + WS_MIX); P.pass = (br); P.mask = nullptr; P.farb = nullptr; \
        att::attn_phase<0>(P, lds, blockIdx.x, gridDim.x, phase_tid(wave0)); } } while (0)
    DIL_PHASE(0);
    DIL_PHASE(1);
    SEAM(7);
    if (IN(9)) REP(9) { KArgP ka = kargs(); unsigned char* ws = ka->ws; bf16_t* T0 = (bf16_t*)(ws + WS_QA);
        att::PhaseP<1> P; P.Q = T0 + 3 * TSTRIDE; P.K = T0 + 4 * TSTRIDE; P.V = T0 + 5 * TSTRIDE; P.tstep = 1; P.skv = SEQ; P.W = 1 << 30;
        P.tab = (const float*)(ws + WS_TABB); P.Oacc = nullptr; P.Lacc = nullptr; P.Oacc2 = nullptr; P.Lacc2 = nullptr; P.Out = (bf16_t*)(ws + WS_MIX); P.pass = 0; P.mask = (const unsigned long long*)(ws + WS_MASK) + (size_t)l * 2 * MASK_B; P.farb = (const float*)(ws + WS_TABB) + 8 * TABB_N;
        att::attn_phase<1>(P, lds, blockIdx.x, gridDim.x, phase_tid(wave0)); }
    DIL_PHASE(2);
    SEAM(9);
#undef DIL_PHASE
    if (IN(10)) { KArgP ka = kargs(); unsigned char* ws = ka->ws; pg8::Gemm g{(const bf16_t*)(ws + WS_MIX), (const bf16_t*)(ws + WS_WOUT), MROWS, DM, DM}; pg8::StaticOrder S; S.init(MROWS, DM, gridDim.x, blockIdx.x);
        pg8::EpiResid<true> E{ka->out, ka->out, DM, 1.0f, (bf16_t*)(ws + WS_H), SSP(ws, 3 * l + 2)}; pg8::gemm_phase<pg8::EpiResid<true>, pg8::StaticOrder, true, true>(lds_las, g, S, E, phase_tid(wave0)); }
    SEAM(10);
    if (IN(11)) REP(11) { KArgP ka = kargs(); unsigned char* ws = ka->ws; pg8::Gemm g{(const bf16_t*)(ws + WS_H), (const bf16_t*)(ws + WS_W2I), MROWS, 2 * DFF, DM}; pg8::StaticOrder S; S.init(MROWS, 2 * DFF, gridDim.x, blockIdx.x);
        pg8::EpiSwiglu E{(bf16_t*)(ws + WS_MID), DFF, SSP(ws, 3 * l + 2)}; pg8::gemm_phase<pg8::EpiSwiglu, pg8::StaticOrder, true, true>(lds_las, g, S, E, phase_tid(wave0)); }
    SEAM(11);
    if (IN(12)) { KArgP ka = kargs(); unsigned char* ws = ka->ws; pg8::Gemm g{(const bf16_t*)(ws + WS_MID), (const bf16_t*)(ws + WS_W2O), MROWS, DM, DFF}; pg8::StaticOrder S; S.init(MROWS, DM, gridDim.x, blockIdx.x);
        pg8::EpiResid<(l + 1 < DEPTH)> E{ka->out, ka->out, DM, 0.5f, (bf16_t*)(ws + WS_H), SSP(ws, l + 1 < DEPTH ? 3 * l + 3 : 0)}; pg8::gemm_phase<pg8::EpiResid<(l + 1 < DEPTH)>, pg8::StaticOrder, true, true>(lds_las, g, S, E, phase_tid(wave0)); }
    SEAM(12);
#undef SSP
}
#undef IN
#undef SEAM
#undef GEOM
__global__ void __launch_bounds__(512, 2) fwd_kernel(Args args_unused) {
    extern __shared__ __attribute__((aligned(16))) unsigned char lds_raw[];
    char* lds = (char*)lds_raw;
    volatile LAS unsigned* misc = (volatile LAS unsigned*)((LAS unsigned char*)lds_raw + MISC_OFF);
    if (threadIdx.x < 64) misc[threadIdx.x] = 0u;
    __syncthreads();
    const int wave0 = __builtin_amdgcn_readfirstlane(threadIdx.x >> 6);
    const int lo = kargs()->ph_lo, hi = kargs()->ph_hi;
    if (hi - lo > 1) (void)xcd_barrier_post((unsigned*)(kargs()->ws + WS_CTL) + 1024, misc + 8);
    run_layer<0>(lo, hi, wave0, lds, (LAS unsigned char*)lds_raw, misc);
    run_layer<1>(lo, hi, wave0, lds, (LAS unsigned char*)lds_raw, misc);
}

extern "C" void kernel_launch(void* const* d_in, const int* in_sizes, int n_in, void* d_out, int out_size, void* d_ws, size_t ws_size, hipStream_t stream) {
    static int grid = 0;
    if (grid == 0) {
        if (n_in != 15 || out_size != MROWS * DM || ws_size < WS_END) { fprintf(stderr, "kernel_launch: unexpected shapes (n_in %d out %d ws %zu)\n", n_in, out_size, ws_size); grid = -1; return; }
        int dev = 0, cus = 0, per_cu = 0;
        if (hipGetDevice(&dev) != hipSuccess || hipDeviceGetAttribute(&cus, hipDeviceAttributeMultiprocessorCount, dev) != hipSuccess) { grid = -1; return; }
        if (hipFuncSetAttribute((const void*)fwd_kernel, hipFuncAttributeMaxDynamicSharedMemorySize, LDS_BYTES) != hipSuccess) { fprintf(stderr, "kernel_launch: hipFuncSetAttribute failed\n"); grid = -1; return; }
        if (hipOccupancyMaxActiveBlocksPerMultiprocessor(&per_cu, (const void*)fwd_kernel, 512, LDS_BYTES) != hipSuccess || per_cu < 1) fprintf(stderr, "kernel_launch: occupancy query reports %d\n", per_cu);
        (void)hipGetLastError();
        grid = cus;
    }
    if (grid < 0) return;
    (void)hipMemsetAsync((char*)d_ws + WS_CTL, 0, CTL_ZERO_BYTES, stream);
    Args a{};
    for (int i = 0; i < 15; ++i) a.in[i] = (const float*)d_in[i];
    a.out = (float*)d_out; a.ws = (unsigned char*)d_ws;
#if MK_ONE_LAUNCH
    a.ph_lo = 0; a.ph_hi = DEPTH * NPH;
    hipLaunchKernelGGL(fwd_kernel, dim3(grid), dim3(512), LDS_BYTES, stream, a);
#else
    for (int p = 0; p < DEPTH * NPH; ++p) { a.ph_lo = p; a.ph_hi = p + 1; hipLaunchKernelGGL(fwd_kernel, dim3(grid), dim3(512), LDS_BYTES, stream, a); }
#endif
}
```

```cpp
#include <hip/hip_runtime.h>
#include <cstdio>
#include <cstdint>

#ifndef MK_ONE_LAUNCH
#define MK_ONE_LAUNCH 1
#endif

#define LAS __attribute__((address_space(3)))
#define GAS __attribute__((address_space(1)))
typedef unsigned short bf16_t;
typedef short bf16x8 __attribute__((ext_vector_type(8)));
typedef short s16x4 __attribute__((ext_vector_type(4)));
typedef float f32x4 __attribute__((ext_vector_type(4)));
typedef float f32x16 __attribute__((ext_vector_type(16)));
typedef unsigned u32x4 __attribute__((ext_vector_type(4)));
typedef unsigned u32x2 __attribute__((ext_vector_type(2)));

constexpr int BATCH = 2, SEQ = 16384, DM = 2048, DEPTH = 2, HD = 128, NHA = 8, NHB = 8, DFF = 5632, NIH = 16, IDIM = 64, TOPK = 256;
constexpr int MROWS = BATCH * SEQ;
constexpr int PROJW = 7248, PROJP = 7424;
constexpr float EPS = 1e-6f;
constexpr float SCALE = 0.08838834764831845f;
constexpr float LOG2E = 1.4426950408889634f;

constexpr size_t MiB = 1u << 20;
constexpr size_t WS_SS = 128 * 1024;
constexpr size_t WS_CTL = 0, CTL_ZERO_BYTES = WS_SS + 6 * (size_t)32768 * 4;
constexpr float SS_SCALE = 256.0f, SS_INV = 1.0f / (256.0f * 2048.0f);
constexpr size_t WS_TABD = 1 * MiB + 768 * 1024;
constexpr size_t WS_TABB = 1 * MiB + 832 * 1024;
constexpr size_t WS_W1I = 2 * MiB, WS_W1O = 46 * MiB, WS_WIN = 68 * MiB, WS_WOUT = 97 * MiB, WS_W2I = 105 * MiB, WS_W2O = 149 * MiB;
constexpr size_t WS_H = 176 * MiB;
constexpr size_t WS_MIX = 688 * MiB;
constexpr size_t WS_QA = 304 * MiB;
constexpr size_t TSTRIDE = (size_t)MROWS * 1024;
constexpr size_t WS_T7 = 752 * MiB;
constexpr size_t WS_MID = 304 * MiB;
constexpr size_t WS_MASK = 816 * MiB;
constexpr size_t MASK_B = 16 * 64 * 65 * 32;
constexpr size_t WS_OACC = 888 * MiB, WS_LACC = 1016 * MiB;
constexpr size_t WS_OACC2 = WS_H, WS_LACC2 = 882 * MiB;
constexpr size_t WS_KIC = 1017 * MiB, WS_WIC = 1021 * MiB;
constexpr size_t WS_END = 1022 * MiB;
static_assert(WS_MASK + 2 * 2 * MASK_B * 8 <= WS_LACC2 && WS_LACC2 + (size_t)MROWS * 8 * 4 <= WS_OACC, "mask buffers");
__host__ __device__ __forceinline__ size_t mask_off(int b, int q) { const int g = q >> 3; return (size_t)b * MASK_B + (size_t)(16 * g * (g + 1) + (q & 7) * (g + 1) * 4) * 32; }
constexpr int TABD_N = 384, TABB_N = 1760, TAB_OFF = 96, FAR_DIST = 1536;

constexpr int LDS_BYTES = 155648;
constexpr int MISC_OFF = 155648 - 256;

__device__ __forceinline__ unsigned cvt_pk_bf16(float lo, float hi) { unsigned r; asm volatile("v_cvt_pk_bf16_f32 %0, %1, %2" : "=v"(r) : "v"(lo), "v"(hi)); return r; }
__device__ __forceinline__ float bf_lo(unsigned w) { return __uint_as_float(w << 16); }
__device__ __forceinline__ float bf_hi(unsigned w) { return __uint_as_float(w & 0xffff0000u); }
template <int K> __device__ __forceinline__ unsigned lane_xor_u(unsigned v) {
    if constexpr (K == 1) return (unsigned)__builtin_amdgcn_update_dpp(0, (int)v, 0xB1, 0xF, 0xF, true);
    else if constexpr (K == 2) return (unsigned)__builtin_amdgcn_update_dpp(0, (int)v, 0x4E, 0xF, 0xF, true);
    else if constexpr (K == 32) { auto rr = __builtin_amdgcn_permlane32_swap(v, v, false, false); const unsigned lane = __builtin_amdgcn_mbcnt_hi(~0u, __builtin_amdgcn_mbcnt_lo(~0u, 0u)); return lane < 32u ? rr[1] : rr[0]; }
    else return (unsigned)__builtin_amdgcn_ds_swizzle((int)v, (K << 10) | 0x1F);
}
template <int K> __device__ __forceinline__ float lane_xor_f(float v) { return __uint_as_float(lane_xor_u<K>(__float_as_uint(v))); }
__device__ __forceinline__ float wave_sum(float v) {
    v += lane_xor_f<1>(v); v += lane_xor_f<2>(v); v += lane_xor_f<4>(v); v += lane_xor_f<8>(v); v += lane_xor_f<16>(v);
    { auto rr = __builtin_amdgcn_permlane32_swap(__float_as_uint(v), __float_as_uint(v), false, false); v = __uint_as_float(rr[0]) + __uint_as_float(rr[1]); }
    return v;
}
__device__ __forceinline__ unsigned wave_max_u(unsigned v) {
    unsigned x;
    x = lane_xor_u<1>(v); v = x > v ? x : v; x = lane_xor_u<2>(v); v = x > v ? x : v; x = lane_xor_u<4>(v); v = x > v ? x : v;
    x = lane_xor_u<8>(v); v = x > v ? x : v; x = lane_xor_u<16>(v); v = x > v ? x : v;
    { auto rr = __builtin_amdgcn_permlane32_swap(v, v, false, false); v = rr[0] > rr[1] ? rr[0] : rr[1]; }
    return v;
}
__device__ __forceinline__ int phase_tid(int wave0) { int lane; asm volatile("v_mbcnt_lo_u32_b32 %0, -1, 0\n\tv_mbcnt_hi_u32_b32 %0, -1, %0" : "=v"(lane), "+s"(wave0)); return wave0 * 64 + lane; }
__device__ __forceinline__ int launder_v(int t) { asm volatile("" : "+v"(t)); return t; }
#define LDS_WAIT() asm volatile("s_waitcnt lgkmcnt(0)" ::: "memory")
#define VM_WAIT() asm volatile("s_waitcnt vmcnt(0)" ::: "memory")

#define XB_TMO      128
#define XB_XCNT(j)  (256  + 64 * (j))
#define XB_XSUB(j)  (1280 + 64 * (j))
#define XB_XGEN(j)  (2304 + 64 * (j))
#define XB_TOP      3328
#define XB_TOPGEN   3392
#define XCD_BAR_WORDS 3456
#define XB_SPIN_CAP (1u << 22)
__device__ __forceinline__ unsigned xb_ld(unsigned* p)              { return __hip_atomic_load(p, __ATOMIC_RELAXED, __HIP_MEMORY_SCOPE_AGENT); }
__device__ __forceinline__ unsigned xb_add(unsigned* p, unsigned v) { return __hip_atomic_fetch_add(p, v, __ATOMIC_RELAXED, __HIP_MEMORY_SCOPE_AGENT); }
__device__ __forceinline__ unsigned xb_xcc_id() { return (unsigned)__builtin_amdgcn_s_getreg((3 << 11) | 20) & 0xFu; }
#define XB_SPIN(cond, bar) do { unsigned _sp = 0; while (cond) { __builtin_amdgcn_s_sleep(1); \
    if ((++_sp & 255u) == 0u) { if (xb_ld(&(bar)[XB_TMO])) break; if (_sp > XB_SPIN_CAP) { atomicAdd(&(bar)[XB_TMO], 1u); break; } } } } while (0)
struct XcdBarrier { unsigned* bar; unsigned x; volatile LAS unsigned* st; };
__device__ __forceinline__ XcdBarrier xcd_barrier_post(unsigned* bar, volatile LAS unsigned* st) {
    XcdBarrier b; b.bar = bar; b.x = xb_xcc_id(); b.st = st;
    if (threadIdx.x == 0) (void)xb_add(&bar[XB_XCNT(b.x)], 1u);
    return b;
}
__device__ __forceinline__ void xcd_barrier_complete(unsigned* bar, unsigned x, unsigned& nloc, unsigned& nx) {
    const unsigned G = gridDim.x * gridDim.y * gridDim.z;
    unsigned sum, cnt, mine, sp = 0u;
    for (;;) {
        sum = 0u; cnt = 0u; mine = 0u;
#pragma unroll
        for (unsigned j = 0; j < 16; ++j) { const unsigned c = xb_ld(&bar[XB_XCNT(j)]); sum += c; cnt += (c > 0u) ? 1u : 0u; mine = (j == x) ? c : mine; }
        if (sum == G) break;
        __builtin_amdgcn_s_sleep(1);
        if ((++sp & 255u) == 0u) { if (xb_ld(&bar[XB_TMO])) break; if (sp > XB_SPIN_CAP) { atomicAdd(&bar[XB_TMO], 1u); break; } }
    }
    nloc = mine > 0u ? mine : 1u; nx = cnt > 0u ? cnt : 1u;
}
__device__ __forceinline__ void xcd_barrier(const XcdBarrier& b) {
    asm volatile("s_waitcnt vmcnt(0)" ::: "memory");
    __syncthreads();
    if (threadIdx.x == 0) {
        unsigned* bar = b.bar;
        __builtin_amdgcn_s_waitcnt(0);
        unsigned nloc = b.st[0], nx = b.st[1];
        if (nloc == 0u) { xcd_barrier_complete(bar, b.x, nloc, nx); b.st[0] = nloc; b.st[1] = nx; }
        const unsigned old = xb_add(&bar[XB_XSUB(b.x)], 1u);
        const unsigned gen = old / nloc;
        if (old + 1u == (gen + 1u) * nloc) {
            __builtin_amdgcn_fence(__ATOMIC_RELEASE, "agent");
            asm volatile("s_waitcnt vmcnt(0)" ::: "memory");
            const unsigned og = xb_add(&bar[XB_TOP], 1u);
            const unsigned tg = og / nx;
            if (og + 1u == (tg + 1u) * nx) xb_add(&bar[XB_TOPGEN], 1u);
            else XB_SPIN(xb_ld(&bar[XB_TOPGEN]) == tg, bar);
            __builtin_amdgcn_fence(__ATOMIC_ACQUIRE, "agent");
            xb_add(&bar[XB_XGEN(b.x)], 1u);
            asm volatile("s_waitcnt vmcnt(0)" ::: "memory");
        } else {
            XB_SPIN(xb_ld(&bar[XB_XGEN(b.x)]) == gen, bar);
            __builtin_amdgcn_fence(__ATOMIC_ACQUIRE, "agent");
            asm volatile("s_waitcnt vmcnt(0)" ::: "memory");
        }
    }
    __syncthreads();
}

namespace pg8 {
constexpr int BM = 256, BK = 64, HALF = 128, HTB = HALF * BK * 2, STAGE_BYTES = 8 * HTB, NXCD = 8, WGM = 4;
__host__ __device__ __forceinline__ int lds_byte(int r, int c) { const int st = (r >> 4) * 2 + (c >> 5), rr = r & 15, cc = c & 31, ob = rr * 64 + cc * 2; return st * 1024 + (ob ^ (((ob >> 9) & 1) << 5)); }
__host__ __device__ __forceinline__ void stage_rc(int b, int& R, int& C) { const int st = b / 1024, sb = b % 1024, swz = sb ^ (((sb >> 9) & 1) << 5); R = (st >> 1) * 16 + swz / 64; C = (st & 1) * 32 + (swz % 64) / 2; }
__host__ __device__ __forceinline__ int perm32(int rho) { const int n = rho >> 4, i = rho & 15; return 8 * (i >> 2) + 4 * n + (i & 3); }
struct Unit { int pm, pn; };
struct Gemm { const bf16_t* A; const bf16_t* Bt; int M, N, K; };
struct StaticOrder {
    int nM, nN, nwg, G, c; bool rev;
    __host__ __device__ void init(int M, int N, int G_, int c_, bool rev_ = false) { nM = M / BM; nN = N / BM; nwg = nM * nN; G = G_; c = c_; rev = rev_; }
    __host__ __device__ bool next(int i, Unit& u) const {
        const long L = (long)i * G + c; if (L >= nwg) return false;
        int wgid = (int)L; { const int q = nwg / NXCD, r = nwg % NXCD, xcd = wgid % NXCD, off = wgid / NXCD; wgid = (xcd < r ? xcd * (q + 1) : r * (q + 1) + (xcd - r) * q) + off; }
        const int nig = WGM * nN, gid = wgid / nig, fm = gid * WGM, gsz = (nM - fm) < WGM ? (nM - fm) : WGM;
        u.pm = fm + ((wgid % nig) % gsz); u.pn = (wgid % nig) / gsz; if (rev) u.pm = nM - 1 - u.pm; return true;
    }
    __device__ __forceinline__ void a_ready(const Unit&) const {}
    __device__ __forceinline__ void done(const Unit&) const {}
};
struct NoPre {};
template <bool XB> struct EpiResid {
    static constexpr bool PERM = true, AFTER_DRAIN = false; typedef NoPre Pre;
    __device__ __forceinline__ Pre pre(const Unit&, int, int) const { return Pre{}; }
    const float* base; float* out; int ldc; float alpha;
    bf16_t* xb; unsigned* ss;
    __device__ __forceinline__ void operator()(const f32x4 (&acc)[2][2][4][2], const Unit& u, int wr, int wc, int fr, int fq, const Pre&) const {
        const float* bp = base; float* op = out; bf16_t* xp = xb; unsigned* sp = ss;
        asm volatile("" : "+s"(bp), "+s"(op), "+s"(xp), "+s"(sp));
        const int row0 = u.pm * BM + wr * 64 + fr, col0 = u.pn * BM + wc * 32 + 8 * fq;
#pragma unroll
        for (int ai = 0; ai < 2; ++ai) {
            f32x4 rb[4][2][2];
#pragma unroll
            for (int m = 0; m < 4; ++m) { const unsigned off = (unsigned)(row0 + ai * HALF + m * 16) * (unsigned)ldc + (unsigned)col0;
#pragma unroll
                for (int bj = 0; bj < 2; ++bj) { rb[m][bj][0] = *(const f32x4*)(bp + off + bj * HALF); rb[m][bj][1] = *(const f32x4*)(bp + off + bj * HALF + 4); } }
            asm volatile("" ::: "memory");
#pragma unroll
            for (int m = 0; m < 4; ++m) { const int row = row0 + ai * HALF + m * 16; const unsigned off = (unsigned)row * (unsigned)ldc + (unsigned)col0; float sq = 0.f;
#pragma unroll
                for (int bj = 0; bj < 2; ++bj) { const f32x4 b0 = rb[m][bj][0], b1 = rb[m][bj][1];
                    const f32x4 v0 = b0 + acc[ai][bj][m][0] * alpha, v1 = b1 + acc[ai][bj][m][1] * alpha;
                    *(f32x4*)(op + off + bj * HALF) = v0; *(f32x4*)(op + off + bj * HALF + 4) = v1;
                    if constexpr (XB) { u32x4 w; w.x = cvt_pk_bf16(v0[0], v0[1]); w.y = cvt_pk_bf16(v0[2], v0[3]); w.z = cvt_pk_bf16(v1[0], v1[1]); w.w = cvt_pk_bf16(v1[2], v1[3]);
                        *(u32x4*)(xp + off + bj * HALF) = w;
                        sq += ((v0[0] * v0[0] + v0[1] * v0[1]) + (v0[2] * v0[2] + v0[3] * v0[3])) + ((v1[0] * v1[0] + v1[1] * v1[1]) + (v1[2] * v1[2] + v1[3] * v1[3])); } }
                if constexpr (XB) { sq += lane_xor_f<16>(sq); sq += lane_xor_f<32>(sq); if (fq == 0) __hip_atomic_fetch_add(sp + row, (unsigned)(sq * SS_SCALE + 0.5f), __ATOMIC_RELAXED, __HIP_MEMORY_SCOPE_AGENT); }
                asm volatile("" ::: "memory"); }
        }
    }
};
__device__ __forceinline__ float silu_mul(float g, float u) { return g * __builtin_amdgcn_rcpf(1.0f + __builtin_amdgcn_exp2f(-g * LOG2E)) * u; }
struct RowSS { unsigned v[8]; };
__device__ __forceinline__ RowSS load_row_ss(const unsigned* ss, const Unit& u, int wr, int fr) {
    RowSS p; const unsigned* sp = ss + u.pm * BM + wr * 64 + fr;
    asm volatile("global_load_dword %0, %8, off\n\tglobal_load_dword %1, %8, off offset:64\n\tglobal_load_dword %2, %8, off offset:128\n\tglobal_load_dword %3, %8, off offset:192\n\t"
                 "global_load_dword %4, %8, off offset:512\n\tglobal_load_dword %5, %8, off offset:576\n\tglobal_load_dword %6, %8, off offset:640\n\tglobal_load_dword %7, %8, off offset:704"
                 : "=&v"(p.v[0]), "=&v"(p.v[1]), "=&v"(p.v[2]), "=&v"(p.v[3]), "=&v"(p.v[4]), "=&v"(p.v[5]), "=&v"(p.v[6]), "=&v"(p.v[7]) : "v"(sp) : "memory");
    return p;
}
struct EpiSwiglu {
    static constexpr bool PERM = true, AFTER_DRAIN = false; typedef RowSS Pre;
    bf16_t* O; int ldc; const unsigned* ss;
    __device__ __forceinline__ Pre pre(const Unit& u, int wr, int fr) const { return load_row_ss(ss, u, wr, fr); }
    __device__ __forceinline__ void operator()(const f32x4 (&acc)[2][2][4][2], const Unit& u, int wr, int wc, int fr, int fq, const Pre& P) const {
        const int row0 = u.pm * BM + wr * 64 + fr, col0 = u.pn * HALF + wc * 32 + 8 * fq;
#pragma unroll
        for (int ai = 0; ai < 2; ++ai)
#pragma unroll
            for (int m = 0; m < 4; ++m) { const int row = row0 + ai * HALF + m * 16; bf16_t* rowp = O + (size_t)row * ldc + col0;
                const float r = __builtin_amdgcn_rsqf((float)P.v[ai * 4 + m] * SS_INV + EPS);
                const f32x4 g0 = acc[ai][0][m][0] * r, g1 = acc[ai][0][m][1] * r, u0 = acc[ai][1][m][0] * r, u1 = acc[ai][1][m][1] * r;
                u32x4 w; w.x = cvt_pk_bf16(silu_mul(g0[0], u0[0]), silu_mul(g0[1], u0[1])); w.y = cvt_pk_bf16(silu_mul(g0[2], u0[2]), silu_mul(g0[3], u0[3]));
                w.z = cvt_pk_bf16(silu_mul(g1[0], u1[0]), silu_mul(g1[1], u1[1])); w.w = cvt_pk_bf16(silu_mul(g1[2], u1[2]), silu_mul(g1[3], u1[3]));
                *(u32x4*)rowp = w; }
    }
};
struct EpiProj {
    static constexpr bool PERM = true, AFTER_DRAIN = false; typedef RowSS Pre;
    bf16_t* T0; const unsigned* ss; bf16_t* kic; bf16_t* wic; LAS float* X;
    __device__ __forceinline__ Pre pre(const Unit& u, int wr, int fr) const { return load_row_ss(ss, u, wr, fr); }
    __device__ __forceinline__ void operator()(const f32x4 (&acc)[2][2][4][2], const Unit& u, int wr, int wc, int fr, int fq, const Pre& P) const {
        const int row0 = u.pm * BM + wr * 64 + fr;
        if (u.pn < 28) {
            const int t = u.pn >> 2; const bool nrm = (t == 0) | (t == 1) | (t == 3) | (t == 4);
            bf16_t* base = T0 + (size_t)t * TSTRIDE + (size_t)row0 * 1024 + (u.pn & 3) * BM + wc * 32 + 8 * fq;
            f32x4 g0 = {1.f, 1.f, 1.f, 1.f}, g1 = {1.f, 1.f, 1.f, 1.f};
            if (nrm) {
#pragma unroll
                for (int ai = 0; ai < 2; ++ai)
#pragma unroll
                    for (int m = 0; m < 4; ++m)
#pragma unroll
                        for (int bj = 0; bj < 2; ++bj) { const f32x4 a0 = acc[ai][bj][m][0], a1 = acc[ai][bj][m][1];
                            float s = ((a0[0] * a0[0] + a0[1] * a0[1]) + (a0[2] * a0[2] + a0[3] * a0[3])) + ((a1[0] * a1[0] + a1[1] * a1[1]) + (a1[2] * a1[2] + a1[3] * a1[3]));
                            s += lane_xor_f<16>(s); s += lane_xor_f<32>(s);
                            if (fq == 0) X[((ai * HALF + wr * 64 + m * 16 + fr) * 2 + bj) * 4 + wc] = s; }
                asm volatile("s_waitcnt lgkmcnt(0)" ::: "memory"); __builtin_amdgcn_s_barrier(); asm volatile("" ::: "memory");
                const LAS float* gp = X + 2048 + (t == 0 ? 0 : (t == 1 ? 128 : (t == 3 ? 256 : 384))) + wc * 32 + 8 * fq;
                g0 = *(const LAS f32x4*)gp; g1 = *(const LAS f32x4*)(gp + 4);
            }
            const float hsc = (t == 0 || t == 3) ? SCALE * LOG2E : 1.0f;
#pragma unroll
            for (int ai = 0; ai < 2; ++ai)
#pragma unroll
                for (int m = 0; m < 4; ++m) { bf16_t* rowp = base + (size_t)(ai * HALF + m * 16) * 1024; const float r = __builtin_amdgcn_rsqf((float)P.v[ai * 4 + m] * SS_INV + EPS);
#pragma unroll
                    for (int bj = 0; bj < 2; ++bj) { float rr = r;
                        if (nrm) { const f32x4 p4 = *(const LAS f32x4*)(X + ((ai * HALF + wr * 64 + m * 16 + fr) * 2 + bj) * 4);
                            const float tot = ((p4[0] + p4[1]) + (p4[2] + p4[3])) * (r * r);
                            rr = r * __builtin_amdgcn_rsqf(tot * (1.0f / HD) + EPS) * hsc; }
                        const f32x4 v0 = acc[ai][bj][m][0] * rr * g0, v1 = acc[ai][bj][m][1] * rr * g1;
                        u32x4 w; w.x = cvt_pk_bf16(v0[0], v0[1]); w.y = cvt_pk_bf16(v0[2], v0[3]); w.z = cvt_pk_bf16(v1[0], v1[1]); w.w = cvt_pk_bf16(v1[2], v1[3]);
                        *(u32x4*)(rowp + bj * HALF) = w; } }
        } else if (wc < 3) {
#pragma unroll
            for (int ai = 0; ai < 2; ++ai)
#pragma unroll
                for (int m = 0; m < 4; ++m) { const size_t row = (size_t)(row0 + ai * HALF + m * 16); const float r = __builtin_amdgcn_rsqf((float)P.v[ai * 4 + m] * SS_INV + EPS);
                    const f32x4 v0 = acc[ai][0][m][0] * r, v1 = acc[ai][0][m][1] * r;
                    u32x4 w; w.x = cvt_pk_bf16(v0[0], v0[1]); w.y = cvt_pk_bf16(v0[2], v0[3]); w.z = cvt_pk_bf16(v1[0], v1[1]); w.w = cvt_pk_bf16(v1[2], v1[3]);
                    if (wc < 2) *(u32x4*)(kic + row * 64 + wc * 32 + 8 * fq) = w; else if (fq < 2) *(u32x4*)(wic + row * 16 + 8 * fq) = w; }
        }
    }
};

template <class Epi, class Sched, bool ALIGN_EPI = false, bool SP2 = false>
__device__ __forceinline__ void gemm_phase(LAS unsigned char* lds, const Gemm g, const Sched& S, const Epi& E, const int tid) {
    const int wid = __builtin_amdgcn_readfirstlane(tid >> 6), lane = tid & 63, wr = wid >> 2, wc = wid & 3, fr = lane & 15, fq = lane >> 4;
    const int K = g.K, nt = K / BK;
    unsigned voffA[2], voffB[2];
#pragma unroll
    for (int i = 0; i < 2; ++i) { int R, C; stage_rc(tid * 16 + i * 8192, R, C); const int Rb = Epi::PERM ? ((R & ~31) + perm32(R & 31)) : R;
        voffA[i] = (unsigned)(R * K + C) * 2u; voffB[i] = (unsigned)(Rb * K + C) * 2u; }
    const size_t kstep = (size_t)(BK * 2);
    const size_t hstep = (size_t)HALF * K * 2;
    const size_t tstep = 2 * hstep;
    const unsigned ldsw = (unsigned)wid * 1024u;
    const int aoff = lds_byte(wr * 64 + fr, fq * 8), boff = lds_byte(wc * 32 + fr, fq * 8);
#define PG8_SA(b, h) (((b) * 2 + (h)) * HTB)
#define PG8_SB(b, h) ((4 + (b) * 2 + (h)) * HTB)
#define PG8_STAGE(bufoff, gbase, voff) do { _Pragma("unroll") for (int _i = 0; _i < 2; ++_i) \
        __builtin_amdgcn_global_load_lds((const unsigned*)((const char*)(gbase) + (voff)[_i]), (LAS unsigned*)(lds + (bufoff) + ldsw + _i * 8192), 16, 0, 0); } while (0)
#define PG8_LDA(dst, b, h) do { _Pragma("unroll") for (int m = 0; m < 4; ++m) _Pragma("unroll") for (int k = 0; k < 2; ++k) dst[m][k] = *(const LAS bf16x8*)(lds + PG8_SA(b, h) + aoff + m * 2048 + k * 1024); } while (0)
#define PG8_LDB(dst, b, h) do { _Pragma("unroll") for (int n = 0; n < 2; ++n) _Pragma("unroll") for (int k = 0; k < 2; ++k) dst[n][k] = *(const LAS bf16x8*)(lds + PG8_SB(b, h) + boff + n * 2048 + k * 1024); } while (0)
#define PG8_MMA(ai, bj, At, Bt) do { __builtin_amdgcn_s_setprio(1); _Pragma("unroll") for (int m = 0; m < 4; ++m) _Pragma("unroll") for (int n = 0; n < 2; ++n) _Pragma("unroll") for (int k = 0; k < 2; ++k) \
        acc[ai][bj][m][n] = __builtin_amdgcn_mfma_f32_16x16x32_bf16(Bt[n][k], At[m][k], acc[ai][bj][m][n], 0, 0, 0); __builtin_amdgcn_s_setprio(0); } while (0)
#define PG8_WAIT_V(n) asm volatile("s_waitcnt vmcnt(" #n ")" ::: "memory")
#define PG8_WAIT_L(n) asm volatile("s_waitcnt lgkmcnt(" #n ")" ::: "memory")
#define PG8_BAR __builtin_amdgcn_s_barrier()
#define PG8_SCHED __builtin_amdgcn_sched_barrier(0)
    Unit cur, nxt; int ui = 0;
    if (!S.next(0, cur)) return;
    f32x4 acc[2][2][4][2];
#pragma unroll
    for (int a = 0; a < 2; ++a)
#pragma unroll
        for (int b = 0; b < 2; ++b)
#pragma unroll
            for (int m = 0; m < 4; ++m)
#pragma unroll
                for (int n = 0; n < 2; ++n) acc[a][b][m][n] = (f32x4){0.f, 0.f, 0.f, 0.f};
    bf16x8 At[4][2], B0[2][2], B1[2][2];
    const char* cA = (const char*)g.A + (size_t)cur.pm * tstep; const char* cB = (const char*)g.Bt + (size_t)cur.pn * tstep;
    S.a_ready(cur);
    if constexpr (SP2) {
        PG8_STAGE(PG8_SB(0, 0), cB, voffB); PG8_STAGE(PG8_SB(0, 1), cB + hstep, voffB); PG8_STAGE(PG8_SA(0, 0), cA, voffA); PG8_STAGE(PG8_SA(0, 1), cA + hstep, voffA);
        if (wr == 1) PG8_BAR;
        PG8_WAIT_V(2); PG8_BAR;
        PG8_STAGE(PG8_SB(1, 0), cB + kstep, voffB); PG8_STAGE(PG8_SA(1, 0), cA + kstep, voffA); PG8_STAGE(PG8_SB(1, 1), cB + hstep + kstep, voffB);
        PG8_WAIT_V(6); PG8_BAR;
    } else {
        PG8_STAGE(PG8_SB(0, 0), cB, voffB); PG8_STAGE(PG8_SA(0, 0), cA, voffA); PG8_STAGE(PG8_SB(0, 1), cB + hstep, voffB); PG8_STAGE(PG8_SA(0, 1), cA + hstep, voffA);
        if (wr == 1) PG8_BAR;
        PG8_WAIT_V(4); PG8_BAR;
        PG8_STAGE(PG8_SB(1, 0), cB + kstep, voffB); PG8_STAGE(PG8_SA(1, 0), cA + kstep, voffA); PG8_STAGE(PG8_SB(1, 1), cB + hstep + kstep, voffB);
        PG8_WAIT_V(6); PG8_BAR;
    }
    for (;;) {
        const bool has_next = S.next(ui + 1, nxt);
        const typename Epi::Pre pre = E.pre(cur, wr, fr);
        const char* nA = has_next ? (const char*)g.A + (size_t)nxt.pm * tstep : cA; const char* nB = has_next ? (const char*)g.Bt + (size_t)nxt.pn * tstep : cB;
        for (int t = 0; t < nt; t += 2) {
            const bool last = (t == nt - 2);
            const char* a1 = cA + (size_t)(t + 1) * kstep;
            const char* a2 = last ? nA : cA + (size_t)(t + 2) * kstep; const char* b2 = last ? nB : cB + (size_t)(t + 2) * kstep;
            const char* a3 = a2 + kstep; const char* b3 = b2 + kstep;
            if (last && has_next) S.a_ready(nxt);
            if constexpr (SP2) {
            PG8_LDB(B0, 0, 0); PG8_LDB(B1, 0, 1); PG8_SCHED; PG8_LDA(At, 0, 0); PG8_STAGE(PG8_SA(1, 1), a1 + hstep, voffA);
            PG8_WAIT_V(8); PG8_WAIT_L(0); PG8_BAR; PG8_MMA(0, 0, At, B0); PG8_MMA(0, 1, At, B1); PG8_BAR; PG8_SCHED;
            PG8_LDA(At, 0, 1); PG8_STAGE(PG8_SB(0, 0), b2, voffB); PG8_STAGE(PG8_SB(0, 1), b2 + hstep, voffB); PG8_STAGE(PG8_SA(0, 0), a2, voffA);
            PG8_WAIT_V(8); PG8_WAIT_L(0); PG8_BAR; PG8_MMA(1, 0, At, B0); PG8_MMA(1, 1, At, B1); PG8_BAR; PG8_SCHED;
            PG8_LDB(B0, 1, 0); PG8_LDB(B1, 1, 1); PG8_SCHED; PG8_LDA(At, 1, 0); PG8_STAGE(PG8_SA(0, 1), a2 + hstep, voffA);
            PG8_WAIT_V(8); PG8_WAIT_L(0); PG8_BAR; PG8_MMA(0, 0, At, B0); PG8_MMA(0, 1, At, B1); PG8_BAR; PG8_SCHED;
            PG8_LDA(At, 1, 1); PG8_STAGE(PG8_SB(1, 0), b3, voffB); PG8_STAGE(PG8_SB(1, 1), b3 + hstep, voffB); PG8_STAGE(PG8_SA(1, 0), a3, voffA);
            PG8_WAIT_V(8); PG8_WAIT_L(0); PG8_BAR; PG8_MMA(1, 0, At, B0); PG8_MMA(1, 1, At, B1); PG8_BAR; PG8_SCHED;
            } else {
            PG8_LDB(B0, 0, 0); PG8_SCHED; PG8_LDA(At, 0, 0); PG8_STAGE(PG8_SA(1, 1), a1 + hstep, voffA);
            PG8_WAIT_L(8); PG8_BAR; PG8_WAIT_L(0); PG8_MMA(0, 0, At, B0); PG8_BAR; PG8_SCHED;
            PG8_LDB(B1, 0, 1); PG8_STAGE(PG8_SB(0, 0), b2, voffB);
            PG8_BAR; PG8_WAIT_L(0); PG8_MMA(0, 1, At, B1); PG8_BAR;
            PG8_LDA(At, 0, 1); PG8_STAGE(PG8_SA(0, 0), a2, voffA);
            PG8_BAR; PG8_WAIT_L(0); PG8_MMA(1, 0, At, B0); PG8_BAR; PG8_SCHED;
            PG8_STAGE(PG8_SB(0, 1), b2 + hstep, voffB);
            PG8_WAIT_V(6); PG8_BAR; PG8_MMA(1, 1, At, B1); PG8_BAR;
            PG8_LDB(B0, 1, 0); PG8_SCHED; PG8_LDA(At, 1, 0); PG8_STAGE(PG8_SA(0, 1), a2 + hstep, voffA);
            PG8_WAIT_L(8); PG8_BAR; PG8_WAIT_L(0); PG8_MMA(0, 0, At, B0); PG8_BAR; PG8_SCHED;
            PG8_LDB(B1, 1, 1); PG8_STAGE(PG8_SB(1, 0), b3, voffB);
            PG8_BAR; PG8_WAIT_L(0); PG8_MMA(0, 1, At, B1); PG8_BAR;
            PG8_LDA(At, 1, 1); PG8_STAGE(PG8_SA(1, 0), a3, voffA);
            PG8_BAR; PG8_WAIT_L(0); PG8_MMA(1, 0, At, B0); PG8_BAR; PG8_SCHED;
            PG8_STAGE(PG8_SB(1, 1), b3 + hstep, voffB);
            PG8_WAIT_V(6); PG8_BAR; PG8_MMA(1, 1, At, B1); PG8_BAR;
            }
        }
        if constexpr (ALIGN_EPI) { if (wr == 0) PG8_BAR; }
        if constexpr (!Epi::AFTER_DRAIN) { E(acc, cur, wr, wc, fr, fq, pre); S.done(cur); }
        if (!has_next) break;
#pragma unroll
        for (int a = 0; a < 2; ++a)
#pragma unroll
            for (int b = 0; b < 2; ++b)
#pragma unroll
                for (int m = 0; m < 4; ++m)
#pragma unroll
                    for (int n = 0; n < 2; ++n) acc[a][b][m][n] = (f32x4){0.f, 0.f, 0.f, 0.f};
        cur = nxt; cA = nA; cB = nB; ++ui;
        if constexpr (ALIGN_EPI) { if (wr == 1) PG8_BAR; }
    }
    PG8_WAIT_V(0);
    if constexpr (!ALIGN_EPI) { if (wr == 0) PG8_BAR; }
    PG8_BAR;
#undef PG8_SA
#undef PG8_SB
#undef PG8_STAGE
#undef PG8_LDA
#undef PG8_LDB
#undef PG8_MMA
#undef PG8_WAIT_V
#undef PG8_WAIT_L
#undef PG8_BAR
#undef PG8_SCHED
}
}

namespace att {
constexpr int D = 128, NW = 8, QBLK = 32, KVBLK = 64, QB = NW * QBLK;
constexpr int SHM_V = KVBLK * D * 2, SHM_K = KVBLK * D * 2;
constexpr int LDS_WS = 2 * SHM_V + 2 * SHM_K;
constexpr int LDS_TAB = LDS_WS + NW * 64 * 4;
constexpr int LDS_Q = LDS_TAB + 7168;
constexpr int ATT_LDS = LDS_Q + NW * 8192;
constexpr float C2 = LOG2E * SCALE;
#define KSWZ(row, colB) ((row) * 256 + ((colB) ^ (((row) & 7) << 4)))
#define SBAR() __builtin_amdgcn_sched_barrier(0)
__device__ __forceinline__ int v_st(int k, int c) { const int kk = (k & ~0xC) | ((k & 4) << 1) | ((k & 8) >> 1); return ((kk >> 3) * 4 + (c >> 5)) * 512 + ((kk & 7) * 32 + (c & 31)) * 2; }
__device__ __forceinline__ int v_rd_base(int lane) { return ((lane & 3) << 3) | (((lane >> 2) & 3) << 6) | (((lane >> 4) & 1) << 5) | (((lane >> 5) & 1) << 8); }
constexpr int v_rd_off(int d0, int ks, int half) { return d0 * 512 + ks * 4096 + half * 2048; }
__device__ __forceinline__ int crow(int r, int hi) { return (r & 3) + 8 * (r >> 2) + 4 * hi; }
__device__ __forceinline__ bf16x8 load8(const bf16_t* p) { return *reinterpret_cast<const bf16x8*>(p); }

__device__ __forceinline__ void mask_tile(f32x16& p0, f32x16& p1, int dq, unsigned W) {
    const float NEG = -__builtin_inff();
#pragma unroll
    for (int r = 0; r < 16; ++r) {
        const int c = (r & 3) + 8 * (r >> 2);
        if ((unsigned)(dq - c) >= W) p0[r] = NEG;
        if ((unsigned)(dq - c - 32) >= W) p1[r] = NEG;
    }
}
__device__ __forceinline__ void bias_tile(f32x16& p0, f32x16& p1, const float* tabL, int dq) {
    const float* bp = tabL + (dq + TAB_OFF - 59);
#pragma unroll
    for (int g = 0; g < 4; ++g) {
        float t0[4], t1[4];
#pragma unroll
        for (int i = 0; i < 4; ++i) { t0[i] = bp[59 - 8 * g - i]; t1[i] = bp[27 - 8 * g - i]; }
#pragma unroll
        for (int i = 0; i < 4; ++i) { p0[4 * g + i] += t0[i]; p1[4 * g + i] += t1[i]; }
        asm volatile("" ::: "memory");
    }
}
typedef unsigned u32x16 __attribute__((ext_vector_type(16)));
struct MaskT { u32x16 a, b, c, d; };
__device__ __forceinline__ float sel_mask(float v, unsigned lo, unsigned hi, float neg) {
    const unsigned long long m = ((unsigned long long)hi << 32) | lo;
    asm volatile("v_cndmask_b32_e64 %0, %1, %0, %2" : "+v"(v) : "v"(neg), "s"(m));
    return v;
}
__device__ __forceinline__ void mask_issue(MaskT& M, const unsigned long long* mt) {
    asm volatile("s_load_dwordx16 %0, %4, 0x0 glc\n\ts_load_dwordx16 %1, %4, 0x40 glc\n\ts_load_dwordx16 %2, %4, 0x80 glc\n\ts_load_dwordx16 %3, %4, 0xc0 glc" : "=&s"(M.a), "=&s"(M.b), "=&s"(M.c), "=&s"(M.d) : "s"(mt));
}
__device__ __forceinline__ void mask_wait(MaskT& M) { asm volatile("s_waitcnt lgkmcnt(0)" : "+s"(M.a), "+s"(M.b), "+s"(M.c), "+s"(M.d)); }
#define MSEL0(v, g, i) sel_mask(v, (g < 2 ? M.a : M.b)[2 * (4 * (g & 1) + i)], (g < 2 ? M.a : M.b)[2 * (4 * (g & 1) + i) + 1], neg)
#define MSEL1(v, g, i) sel_mask(v, (g < 2 ? M.c : M.d)[2 * (4 * (g & 1) + i)], (g < 2 ? M.c : M.d)[2 * (4 * (g & 1) + i) + 1], neg)
__device__ __forceinline__ void arg_tile_far(f32x16& p0, f32x16& p1, const MaskT& M, float neg) {
#pragma unroll
    for (int g = 0; g < 4; ++g) {
#pragma unroll
        for (int i = 0; i < 4; ++i) { p0[4 * g + i] = MSEL0(p0[4 * g + i], g, i); p1[4 * g + i] = MSEL1(p1[4 * g + i], g, i); }
        __builtin_amdgcn_sched_barrier(0);
    }
}
__device__ __forceinline__ void arg_tile_near(f32x16& p0, f32x16& p1, const float* tabL, int dq, const MaskT& M, float neg) {
    const float* bp = tabL + (dq + TAB_OFF - 59);
#pragma unroll
    for (int g = 0; g < 4; ++g) {
        float t0[4], t1[4];
#pragma unroll
        for (int i = 0; i < 4; ++i) { t0[i] = bp[59 - 8 * g - i]; t1[i] = bp[27 - 8 * g - i]; }
#pragma unroll
        for (int i = 0; i < 4; ++i) { p0[4 * g + i] = MSEL0(p0[4 * g + i] + t0[i], g, i); p1[4 * g + i] = MSEL1(p1[4 * g + i] + t1[i], g, i); }
        __builtin_amdgcn_sched_barrier(0);
    }
}
__device__ __forceinline__ void exp_half(f32x16& p) {
#pragma unroll
    for (int r = 0; r < 16; ++r) p[r] = __builtin_amdgcn_exp2f(p[r]);
}
constexpr float THR = 8.f;
__device__ __forceinline__ void partialSM(f32x16& p0, f32x16& p1, float& m_reg, float& mn, float& alpha) {
    float pmax = p0[0];
#pragma unroll
    for (int r = 1; r < 16; ++r) pmax = fmaxf(pmax, p0[r]);
#pragma unroll
    for (int r = 0; r < 16; ++r) pmax = fmaxf(pmax, p1[r]);
    { auto rr = __builtin_amdgcn_permlane32_swap(__float_as_uint(pmax), __float_as_uint(pmax), false, false);
      pmax = fmaxf(__uint_as_float(rr[0]), __uint_as_float(rr[1])); }
    if (__builtin_expect(__all((pmax - m_reg) * SCALE <= THR), 1)) { mn = m_reg; alpha = 1.f; }
    else { mn = fmaxf(m_reg, pmax); alpha = __builtin_amdgcn_exp2f((m_reg - mn) * C2); m_reg = mn; }
    const float mnL = -mn * C2;
#pragma unroll
    for (int r = 0; r < 16; ++r) p0[r] = fmaf(p0[r], C2, mnL);
#pragma unroll
    for (int r = 0; r < 16; ++r) p1[r] = fmaf(p1[r], C2, mnL);
#pragma unroll
    for (int r = 0; r < 16; ++r) p0[r] = __builtin_amdgcn_exp2f(p0[r]);
}
__device__ __forceinline__ void finishSM(f32x16& p0, f32x16& p1, float alpha, float& l_reg, bf16x8& pa0, bf16x8& pa1, bf16x8& pa2, bf16x8& pa3) {
#pragma unroll
    for (int r = 0; r < 16; ++r) p1[r] = __builtin_amdgcn_exp2f(p1[r]);
    float ps = 0;
#pragma unroll
    for (int r = 0; r < 16; ++r) ps += p0[r];
#pragma unroll
    for (int r = 0; r < 16; ++r) ps += p1[r];
    { auto rr = __builtin_amdgcn_permlane32_swap(__float_as_uint(ps), __float_as_uint(ps), false, false);
      ps = __uint_as_float(rr[0]) + __uint_as_float(rr[1]); }
    l_reg = l_reg * alpha + ps;
#define PK4(P, B_, OUT) do { unsigned a0 = cvt_pk_bf16(P[B_+0], P[B_+1]), a1 = cvt_pk_bf16(P[B_+2], P[B_+3]);                          \
        unsigned b0 = cvt_pk_bf16(P[B_+4], P[B_+5]), b1 = cvt_pk_bf16(P[B_+6], P[B_+7]);                                             \
        auto r0 = __builtin_amdgcn_permlane32_swap(a0, b0, false, false); auto r1 = __builtin_amdgcn_permlane32_swap(a1, b1, false, false); \
        u32x4 w = {r0[0], r1[0], r0[1], r1[1]}; OUT = *reinterpret_cast<bf16x8*>(&w); } while (0)
    PK4(p0, 0, pa0); PK4(p0, 8, pa1); PK4(p1, 0, pa2); PK4(p1, 8, pa3);
#undef PK4
}
__device__ __forceinline__ void finishSM1(f32x16& p0, f32x16& p1, float& l_reg, bf16x8& pa0, bf16x8& pa1, bf16x8& pa2, bf16x8& pa3) {
    exp_half(p1);
    float ps = 0;
#pragma unroll
    for (int r = 0; r < 16; ++r) ps += p0[r];
#pragma unroll
    for (int r = 0; r < 16; ++r) ps += p1[r];
    { auto rr = __builtin_amdgcn_permlane32_swap(__float_as_uint(ps), __float_as_uint(ps), false, false);
      ps = __uint_as_float(rr[0]) + __uint_as_float(rr[1]); }
    l_reg += ps;
#define PK4(P, B_, OUT) do { unsigned a0 = cvt_pk_bf16(P[B_+0], P[B_+1]), a1 = cvt_pk_bf16(P[B_+2], P[B_+3]);                          \
        unsigned b0 = cvt_pk_bf16(P[B_+4], P[B_+5]), b1 = cvt_pk_bf16(P[B_+6], P[B_+7]);                                             \
        auto r0 = __builtin_amdgcn_permlane32_swap(a0, b0, false, false); auto r1 = __builtin_amdgcn_permlane32_swap(a1, b1, false, false); \
        u32x4 w = {r0[0], r1[0], r0[1], r1[1]}; OUT = *reinterpret_cast<bf16x8*>(&w); } while (0)
    PK4(p0, 0, pa0); PK4(p0, 8, pa1); PK4(p1, 0, pa2); PK4(p1, 8, pa3);
#undef PK4
}
template <int KB, bool SK, bool QREG>
__device__ __forceinline__ void qkt(f32x16& p0, f32x16& p1, const char* K_lds, int r32, int hi, const char* qb, const bf16x8* qr, bool act, float init) {
    if (SK && !act) { const float NEG = -__builtin_inff();
#pragma unroll
        for (int r = 0; r < 16; ++r) { p0[r] = NEG; p1[r] = NEG; } return; }
#pragma unroll
    for (int r = 0; r < 16; ++r) { p0[r] = init; p1[r] = init; }
    const char* kb[4];
#pragma unroll
    for (int dd = 0; dd < 4; ++dd) kb[dd] = K_lds + KB * SHM_K + KSWZ(r32, (dd * 16 + hi * 8) * 2);
#pragma unroll
    for (int d0 = 0; d0 < 8; ++d0) { const char* a = kb[d0 & 3] + (d0 >> 2) * 128;
        bf16x8 b0 = *reinterpret_cast<const bf16x8*>(a);
        bf16x8 b1 = *reinterpret_cast<const bf16x8*>(a + 32 * 256);
        const bf16x8 q = QREG ? qr[d0] : *reinterpret_cast<const bf16x8*>(qb + d0 * 1024);
        p0 = __builtin_amdgcn_mfma_f32_32x32x16_bf16(b0, q, p0, 0, 0, 0);
        p1 = __builtin_amdgcn_mfma_f32_32x32x16_bf16(b1, q, p1, 0, 0, 0); }
}
template <int VB, bool SK>
__device__ __forceinline__ void pv_tile(f32x16* o, int vb0, bf16x8 pa0, bf16x8 pa1, bf16x8 pa2, bf16x8 pa3, bool act) {
    if (SK && !act) return;
#define TRRD(dst, off) asm volatile("ds_read_b64_tr_b16 %0, %1 offset:%2" : "=&v"(dst) : "v"(vb0), "i"(off) : "memory")
#define PV_D0(d0) do { s16x4 l0, l1, l2, l3, h0, h1, h2, h3; constexpr int b_ = VB * SHM_V + v_rd_off(d0, 0, 0); \
        TRRD(l0, b_); TRRD(h0, b_ + 2048); TRRD(l1, b_ + 4096); TRRD(h1, b_ + 6144); TRRD(l2, b_ + 8192); TRRD(h2, b_ + 10240); TRRD(l3, b_ + 12288); TRRD(h3, b_ + 14336); \
        asm volatile("s_waitcnt lgkmcnt(0)" ::: "memory"); SBAR(); \
        o[d0] = __builtin_amdgcn_mfma_f32_32x32x16_bf16(pa0, (bf16x8){l0[0], l0[1], l0[2], l0[3], h0[0], h0[1], h0[2], h0[3]}, o[d0], 0, 0, 0);   \
        o[d0] = __builtin_amdgcn_mfma_f32_32x32x16_bf16(pa1, (bf16x8){l1[0], l1[1], l1[2], l1[3], h1[0], h1[1], h1[2], h1[3]}, o[d0], 0, 0, 0);   \
        o[d0] = __builtin_amdgcn_mfma_f32_32x32x16_bf16(pa2, (bf16x8){l2[0], l2[1], l2[2], l2[3], h2[0], h2[1], h2[2], h2[3]}, o[d0], 0, 0, 0);   \
        o[d0] = __builtin_amdgcn_mfma_f32_32x32x16_bf16(pa3, (bf16x8){l3[0], l3[1], l3[2], l3[3], h3[0], h3[1], h3[2], h3[3]}, o[d0], 0, 0, 0); } while (0)
    PV_D0(0); PV_D0(1); PV_D0(2); PV_D0(3);
#undef PV_D0
#undef TRRD
}

template <int KB, bool SK>
__device__ __forceinline__ void qkt_fsm1(f32x16& x0, f32x16& x1, const char* K_lds, int r32, int hi, const bf16x8* qr, float init,
                                         f32x16& y0, f32x16& y1, float& l_reg, bf16x8& pa0, bf16x8& pa1, bf16x8& pa2, bf16x8& pa3, bool act) {
    if (SK && !act) { const float NEG = -__builtin_inff();
#pragma unroll
        for (int r = 0; r < 16; ++r) { x0[r] = NEG; x1[r] = NEG; }
        finishSM1(y0, y1, l_reg, pa0, pa1, pa2, pa3); return; }
#pragma unroll
    for (int r = 0; r < 16; ++r) { x0[r] = init; x1[r] = init; }
    const char* kb[4];
#pragma unroll
    for (int dd = 0; dd < 4; ++dd) kb[dd] = K_lds + KB * SHM_K + KSWZ(r32, (dd * 16 + hi * 8) * 2);
    bf16x8 k0 = *reinterpret_cast<const bf16x8*>(kb[0]), k1 = *reinterpret_cast<const bf16x8*>(kb[0] + 32 * 256);
    float ps = 0.f;
#define PK4(P, B_, OUT) do { unsigned a0 = cvt_pk_bf16(P[B_+0], P[B_+1]), a1 = cvt_pk_bf16(P[B_+2], P[B_+3]);                          \
        unsigned b0 = cvt_pk_bf16(P[B_+4], P[B_+5]), b1 = cvt_pk_bf16(P[B_+6], P[B_+7]);                                             \
        auto r0 = __builtin_amdgcn_permlane32_swap(a0, b0, false, false); auto r1 = __builtin_amdgcn_permlane32_swap(a1, b1, false, false); \
        u32x4 w = {r0[0], r1[0], r0[1], r1[1]}; OUT = *reinterpret_cast<bf16x8*>(&w); } while (0)
#pragma unroll
    for (int d0 = 0; d0 < 8; ++d0) {
        x0 = __builtin_amdgcn_mfma_f32_32x32x16_bf16(k0, qr[d0], x0, 0, 0, 0);
        x1 = __builtin_amdgcn_mfma_f32_32x32x16_bf16(k1, qr[d0], x1, 0, 0, 0);
        if (d0 + 1 < 8) { const char* a = kb[(d0 + 1) & 3] + ((d0 + 1) >> 2) * 128; k0 = *reinterpret_cast<const bf16x8*>(a); k1 = *reinterpret_cast<const bf16x8*>(a + 32 * 256); }
        SBAR();
        if (d0 < 4) {
#pragma unroll
            for (int i = 0; i < 4; ++i) { y1[4 * d0 + i] = __builtin_amdgcn_exp2f(y1[4 * d0 + i]); ps += y0[4 * d0 + i]; }
        } else if (d0 == 4) {
#pragma unroll
            for (int i = 0; i < 8; ++i) ps += y1[i];
        } else if (d0 == 5) {
#pragma unroll
            for (int i = 8; i < 16; ++i) ps += y1[i];
            auto rr = __builtin_amdgcn_permlane32_swap(__float_as_uint(ps), __float_as_uint(ps), false, false);
            l_reg += __uint_as_float(rr[0]) + __uint_as_float(rr[1]);
        } else if (d0 == 6) { PK4(y0, 0, pa0); PK4(y0, 8, pa1); }
        else { PK4(y1, 0, pa2); PK4(y1, 8, pa3); }
        SBAR();
    }
#undef PK4
}
template <int VB>
__device__ __forceinline__ void pv_maskt1(f32x16* o, int vb0, bf16x8 pa0, bf16x8 pa1, bf16x8 pa2, bf16x8 pa3, f32x16& x0, f32x16& x1, MaskT& M, float neg) {
#define TRRD(dst, off) asm volatile("ds_read_b64_tr_b16 %0, %1 offset:%2" : "=&v"(dst) : "v"(vb0), "i"(off) : "memory")
#define PV_D0(d0) do { s16x4 l0, l1, l2, l3, h0, h1, h2, h3; constexpr int b_ = VB * SHM_V + v_rd_off(d0, 0, 0); \
        TRRD(l0, b_); TRRD(h0, b_ + 2048); TRRD(l1, b_ + 4096); TRRD(h1, b_ + 6144); TRRD(l2, b_ + 8192); TRRD(h2, b_ + 10240); TRRD(l3, b_ + 12288); TRRD(h3, b_ + 14336); \
        asm volatile("s_waitcnt lgkmcnt(0)" ::: "memory"); SBAR(); \
        o[d0] = __builtin_amdgcn_mfma_f32_32x32x16_bf16(pa0, (bf16x8){l0[0], l0[1], l0[2], l0[3], h0[0], h0[1], h0[2], h0[3]}, o[d0], 0, 0, 0);   \
        o[d0] = __builtin_amdgcn_mfma_f32_32x32x16_bf16(pa1, (bf16x8){l1[0], l1[1], l1[2], l1[3], h1[0], h1[1], h1[2], h1[3]}, o[d0], 0, 0, 0);   \
        o[d0] = __builtin_amdgcn_mfma_f32_32x32x16_bf16(pa2, (bf16x8){l2[0], l2[1], l2[2], l2[3], h2[0], h2[1], h2[2], h2[3]}, o[d0], 0, 0, 0);   \
        o[d0] = __builtin_amdgcn_mfma_f32_32x32x16_bf16(pa3, (bf16x8){l3[0], l3[1], l3[2], l3[3], h3[0], h3[1], h3[2], h3[3]}, o[d0], 0, 0, 0); SBAR(); } while (0)
#define MQ(g) do { _Pragma("unroll") for (int i = 0; i < 4; ++i) { x0[4 * (g) + i] = __builtin_amdgcn_exp2f(MSEL0(x0[4 * (g) + i], (g), i)); x1[4 * (g) + i] = MSEL1(x1[4 * (g) + i], (g), i); } SBAR(); } while (0)
    PV_D0(0); PV_D0(1); mask_wait(M); MQ(0); PV_D0(2); MQ(1); PV_D0(3); MQ(2); MQ(3);
#undef MQ
#undef PV_D0
#undef TRRD
}

struct Blk { int tok0, h, P0; };
struct Seam { bf16x8 qr[8]; bf16x8 st0, st1; };
template <int MODE> struct PhaseP {
    const bf16_t* Q; const bf16_t* K; const bf16_t* V;
    int tstep, skv, W;
    const float* tab;
    bf16_t* Oacc; float* Lacc; bf16_t* Oacc2; float* Lacc2; bf16_t* Out; int pass;
    const unsigned long long* mask; const float* farb;
};
__device__ __forceinline__ int swa_jlo(int P0, int W) { const int lowk = P0 - W + 1; return lowk > 0 ? lowk / KVBLK : 0; }
#define AROW(p, b, m) ((p) + ((size_t)((b).tok0 + (m) * P.tstep) * 1024 + (b).h * 128))
#define VMW() asm volatile("s_waitcnt vmcnt(0)" ::: "memory")
#define VMWN(n) asm volatile("s_waitcnt vmcnt(%0)" :: "i"(n) : "memory")
#define UROW(p, b, m) ((const char*)((p) + ((size_t)((b).tok0 + (m) * P.tstep) * 1024 + (b).h * 128)))
#define SLOAD_K(b, k0) do { const char* kp_ = UROW(P.K, b, k0); S.st0 = *(const bf16x8*)(kp_ + loff0); S.st1 = *(const bf16x8*)(kp_ + loff1); } while (0)
#define SLOAD_V(b, k0) do { const char* vp_ = UROW(P.V, b, k0); S.st0 = *(const bf16x8*)(vp_ + loff0); S.st1 = *(const bf16x8*)(vp_ + loff1); } while (0)
#define QLOAD(b) do { const char* qp_ = UROW(P.Q, b, (b).P0 + wid * QBLK); _Pragma("unroll") for (int d0 = 0; d0 < 8; ++d0) S.qr[d0] = *(const bf16x8*)(qp_ + qoff + d0 * 32); } while (0)
#define LANE_OFFS() const unsigned loff0 = (unsigned)(sr * P.tstep * 1024 + sc) * 2u, loff1 = loff0 + (unsigned)(32 * P.tstep) * 2048u, qoff = (unsigned)(r32 * P.tstep * 1024 + hi * 8) * 2u
#define SWRITE_K(bf) do { *(bf16x8*)(K_lds + (bf) * SHM_K + kws) = S.st0; *(bf16x8*)(K_lds + (bf) * SHM_K + kws + 32 * 256) = S.st1; } while (0)
#define SWRITE_VO(off) do { *(bf16x8*)(V_lds + (off) + vst0) = S.st0; *(bf16x8*)(V_lds + (off) + vst1) = S.st1; } while (0)
template <int MODE>
__device__ __forceinline__ void attn_prime(const PhaseP<MODE>& P, const Blk& cur, char* lds, Seam& S, const int tid) {
    const int wid = __builtin_amdgcn_readfirstlane(tid >> 6), lane = tid & 63, r32 = lane & 31, hi = lane >> 5;
    const int sr = tid >> 4, sc = (tid & 15) * 8, kws = KSWZ(sr, sc * 2); char* K_lds = lds + 2 * SHM_V;
    const int kb0 = swa_jlo(cur.P0, P.W) * KVBLK;
    LANE_OFFS();
    QLOAD(cur);
    SLOAD_K(cur, kb0); VMW(); SWRITE_K(0); SBAR(); SLOAD_V(cur, kb0);
    __syncthreads();
}
template <int MODE>
__device__ __forceinline__ void attn_block(const PhaseP<MODE>& P, const Blk& cur, const Blk& nxt, char* lds, Seam& S, const int tid_phase) {
    const int tid = launder_v(tid_phase);
    const int wid = __builtin_amdgcn_readfirstlane(tid >> 6), lane = tid & 63, r32 = lane & 31, hi = lane >> 5;
    const int W = P.W, skv = P.skv;
    const int j_lo = swa_jlo(cur.P0, W);
    int j_hi = (cur.P0 + QB - 1) / KVBLK + 1; if (j_hi > skv / KVBLK) j_hi = skv / KVBLK;
    const int NT = j_hi - j_lo;
    const int kbn = swa_jlo(nxt.P0, W) * KVBLK;
    const int qlo = cur.P0 + wid * QBLK, qm = qlo + r32 - 4 * hi;
    char* V_lds = lds; char* K_lds = lds + 2 * SHM_V;
    float* ws = (float*)(lds + LDS_WS) + wid * 64; float* li_l = ws, * al_l = ws + 32;
    float* tabL = (float*)(lds + LDS_TAB);
    char* qb = lds + LDS_Q + wid * 8192 + lane * 16;
    constexpr bool QREG = true;
    if constexpr (!QREG) {
#pragma unroll
        for (int d0 = 0; d0 < 8; ++d0) *(bf16x8*)(qb + d0 * 1024) = S.qr[d0]; }
    { constexpr int TN4 = (MODE == 0 ? TABD_N : TABB_N) / 4; const f32x4* tg = (const f32x4*)(P.tab + (size_t)cur.h * (MODE == 0 ? TABD_N : TABB_N));
      static_assert(TN4 <= 512, "one copy per thread"); if (tid < TN4) ((f32x4*)tabL)[tid] = tg[tid];
      __syncthreads(); }
    float farb = 0.f; const unsigned long long* mrow = nullptr; const float neginf = -__builtin_inff(); MaskT MK; unsigned mtouch = 0u; const unsigned lane4 = (unsigned)lane * 4u; (void)lane4;
    if constexpr (MODE == 1) { farb = P.farb[cur.h];
        mrow = P.mask + mask_off(cur.tok0 / SEQ, qlo >> 5); }
    float m_reg = -1e30f, l_reg = 0; f32x16 o[4] = {};
    const int sr = tid >> 4, sc = (tid & 15) * 8, vst0 = v_st(sr, sc), vst1 = v_st(32 + sr, sc), kws = KSWZ(sr, sc * 2);
    const int vb0 = (int)(uintptr_t)V_lds + v_rd_base(lane);
    const unsigned loff0 = (unsigned)(sr * P.tstep * 1024 + sc) * 2u, loff1 = loff0 + (unsigned)(32 * P.tstep) * 2048u;
#define RESC(a) do { if constexpr (false) if (__any((a) < 1.f)) { if (hi == 0) al_l[r32] = (a); asm volatile("s_waitcnt lgkmcnt(0)" ::: "memory");              \
                     for (int d_ = 0; d_ < 4; ++d_) for (int r = 0; r < 16; ++r) o[d_][r] *= (al_l + 4 * hi)[(r & 3) + 8 * (r >> 2)]; } } while (0)
#define KBASE(t) ((j_lo + (t)) * KVBLK)
#define ACT(t) (KBASE(t) <= qlo + QBLK - 1 && KBASE(t) + KVBLK - 1 >= qlo - W + 1)
    constexpr bool SK = (MODE == 0);
#define MASKT(P0_, P1_, t) do { const int kb_ = KBASE(t); \
        if constexpr (MODE == 0) { if (ACT(t)) { bias_tile(P0_, P1_, tabL, qm - kb_); \
                if (kb_ + KVBLK - 1 > qlo || kb_ <= qlo + QBLK - 1 - W) mask_tile(P0_, P1_, qm - kb_, (unsigned)W); } } \
        else { mask_wait(MK); if (FAR_T(t)) arg_tile_far(P0_, P1_, MK, neginf); else arg_tile_near(P0_, P1_, tabL, qm - kb_, MK, neginf); } } while (0)
  \
#define MTOUCH(t) do { if constexpr (MODE == 1) { if ((t) + 2 < NT) { const char* mp_ = (const char*)(mrow + (size_t)(j_lo + (t) + 2) * 32); \
        asm volatile("global_load_dword %0, %1, %2" : "+v"(mtouch) : "v"(lane4), "s"(mp_) : "memory"); } } } while (0)
#define MLOAD(t) do { if constexpr (MODE == 1) mask_issue(MK, mrow + (size_t)(j_lo + (t)) * 32); } while (0)
#define FAR_T(t) (MODE == 1 && qlo - (KBASE(t) + KVBLK - 1) >= FAR_DIST)
#define QINIT(t) (FAR_T(t) ? farb : 0.f)
#define PSM(P0_, P1_, mn_, al_) do { exp_half(P0_); } while (0)
#define FSM(P0_, P1_, al_) do { finishSM1(P0_, P1_, l_reg, pa0, pa1, pa2, pa3); } while (0)
    constexpr int NQL = 8;
#define SEAM_K0() do { VMWN(NQL); SWRITE_K(0); SBAR(); SLOAD_V(nxt, kbn); SBAR(); } while (0)
    f32x16 pA0, pA1, pB0, pB1; float mnA = 0.f, mnB = 0.f, alA = 1.f, alB = 1.f; bf16x8 pa0, pa1, pa2, pa3; (void)mnA; (void)mnB;
    int r0 = 0, r1 = SHM_V, r2 = LDS_Q;
#define VROT() do { const int r_ = r0; r0 = r1; r1 = r2; r2 = r_; } while (0)
    VMW(); SWRITE_VO(0); SBAR();
    if (NT > 1) { SLOAD_K(cur, KBASE(1)); }
    MLOAD(0); MTOUCH(-1); MTOUCH(0); SBAR(); qkt<0, SK, QREG>(pA0, pA1, K_lds, r32, hi, qb, S.qr, ACT(0), QINIT(0));
    if (NT > 1) { VMW(); SWRITE_K(1); SBAR(); SLOAD_V(cur, KBASE(1)); SBAR(); }
    MASKT(pA0, pA1, 0); PSM(pA0, pA1, mnA, alA);
    if (NT > 1) { VMW(); SWRITE_VO(SHM_V); SBAR(); if (NT > 2) SLOAD_K(cur, KBASE(2)); }
    __syncthreads();
#define HALF_STEP(PX0, PX1, mnX, alX, PY0, PY1, alY, t, KB, VB, SB) do {                                                      \
        SBAR(); qkt_fsm1<KB, SK>(PX0, PX1, K_lds, r32, hi, S.qr, QINIT(t), PY0, PY1, l_reg, pa0, pa1, pa2, pa3, ACT(t)); SBAR();   \
        if ((t) + 1 < NT) { VMW(); SWRITE_K(SB); SBAR(); SLOAD_V(cur, KBASE((t) + 1)); SBAR(); }                         \
        MLOAD(t); MTOUCH(t); SBAR();                                                                                   \
        pv_tile<0, SK>(o, vb0 + r0, pa0, pa1, pa2, pa3, ACT((t) - 1)); MASKT(PX0, PX1, (t)); PSM(PX0, PX1, mnX, alX);   \
        if ((t) + 1 < NT) { VMW(); SWRITE_VO(r2); SBAR(); if ((t) + 2 < NT) SLOAD_K(cur, KBASE((t) + 2)); }              \
        VROT();                                                                                                           \
        __syncthreads(); } while (0)
    for (int t = 1; t + 1 < NT; t += 2) {
        HALF_STEP(pB0, pB1, mnB, alB, pA0, pA1, alA, t, 1, 0, 0);
        HALF_STEP(pA0, pA1, mnA, alA, pB0, pB1, alB, t + 1, 0, 1, 1);
    }
    const bool even = (NT & 1) == 0;
    asm volatile("" :: "v"(mtouch));
    if (even) { SBAR(); qkt<1, SK, QREG>(pB0, pB1, K_lds, r32, hi, qb, S.qr, ACT(NT - 1), QINIT(NT - 1)); SBAR(); }
    SLOAD_K(nxt, kbn); SBAR();
    { const int tq_ = launder_v(tid_phase), r32q = tq_ & 31, hiq = (tq_ >> 5) & 1; const unsigned qoffq = (unsigned)(r32q * P.tstep * 1024 + hiq * 8) * 2u;
      const char* qp_ = UROW(P.Q, nxt, nxt.P0 + wid * QBLK);
#pragma unroll
      for (int d0 = 0; d0 < 8; ++d0) S.qr[d0] = *(const bf16x8*)(qp_ + qoffq + d0 * 32); }
    SBAR();
    if (even) MLOAD(NT - 1);
    FSM(pA0, pA1, alA); SBAR();
    pv_tile<0, SK>(o, vb0 + r0, pa0, pa1, pa2, pa3, ACT(even ? NT - 2 : NT - 1));
    if (even) { MASKT(pB0, pB1, NT - 1); PSM(pB0, pB1, mnB, alB); __syncthreads(); RESC(alB);
        FSM(pB0, pB1, alB); SBAR(); pv_tile<0, SK>(o, vb0 + r1, pa0, pa1, pa2, pa3, ACT(NT - 1)); }
    SBAR(); SEAM_K0();
    const int te_ = launder_v(tid_phase), r32e = te_ & 31, hie = (te_ >> 5) & 1;
    if constexpr (MODE == 1) {
        if (hie == 0) li_l[r32e] = l_reg; asm volatile("s_waitcnt lgkmcnt(0)" ::: "memory");
        const float* lih = li_l + 4 * hie;
        bf16_t* Ob = P.Out + ((size_t)(cur.tok0 + qlo + 4 * hie) * 2048 + 1024 + cur.h * 128 + r32e);
#pragma unroll
        for (int r = 0; r < 16; ++r) { const int cr = (r & 3) + 8 * (r >> 2); const float rl = __builtin_amdgcn_rcpf(lih[cr]);
#pragma unroll
            for (int d0 = 0; d0 < 4; ++d0) { const float v = o[d0][r] * rl; const float vn = lane_xor_f<1>(v);
                if ((r32e & 1) == 0) *(unsigned*)(Ob + (size_t)cr * 2048 + d0 * 32) = cvt_pk_bf16(v, vn); } }
    } else {
        float lf = l_reg;
        const int pass = P.pass, ts = P.tstep;
        if (hie == 0) { const size_t li = (size_t)(cur.tok0 + (qlo + r32e) * ts) * 8 + cur.h;
            if (pass == 0) P.Lacc[li] = lf; else if (pass == 1) P.Lacc2[li] = lf; else lf += P.Lacc[li] + P.Lacc2[li];
            li_l[r32e] = lf; }
        asm volatile("s_waitcnt lgkmcnt(0)" ::: "memory");
        const float* lih = li_l + 4 * hie;
        const size_t tokb = (size_t)(cur.tok0 + (qlo + 4 * hie) * ts);
        const size_t oofs = tokb * 1024 + cur.h * 128 + r32e;
        if (pass != 2) {
            bf16_t* Odst = (pass == 0 ? P.Oacc : P.Oacc2) + oofs;
#pragma unroll
            for (int r = 0; r < 16; ++r) { const int cr = (r & 3) + 8 * (r >> 2); bf16_t* Oa = Odst + (size_t)(cr * ts) * 1024;
#pragma unroll
                for (int d0 = 0; d0 < 4; ++d0) { const float v = o[d0][r]; const float vn = lane_xor_f<1>(v);
                    if ((r32e & 1) == 0) *(unsigned*)(Oa + d0 * 32) = cvt_pk_bf16(v, vn); } }
        } else {
            const int odd = r32e & 1;
            const bf16_t* Oab = P.Oacc + oofs - odd; const bf16_t* Obb = P.Oacc2 + oofs - odd; bf16_t* Owb = P.Out + tokb * 2048 + cur.h * 128 + r32e;
            unsigned pa_[16][4], pb_[16][4];
#pragma unroll
            for (int r = 0; r < 16; ++r) { const int cr = (r & 3) + 8 * (r >> 2); const size_t ro = (size_t)(cr * ts) * 1024;
#pragma unroll
                for (int d0 = 0; d0 < 4; ++d0) { pa_[r][d0] = *(const unsigned*)(Oab + ro + d0 * 32); pb_[r][d0] = *(const unsigned*)(Obb + ro + d0 * 32); } }
#pragma unroll
            for (int r = 0; r < 16; ++r) { const int cr = (r & 3) + 8 * (r >> 2); const float rl = __builtin_amdgcn_rcpf(lih[cr]); bf16_t* Ow = Owb + (size_t)(cr * ts) * 2048;
#pragma unroll
                for (int d0 = 0; d0 < 4; ++d0) { const float fa = __uint_as_float(odd ? (pa_[r][d0] & 0xffff0000u) : (pa_[r][d0] << 16)), fb = __uint_as_float(odd ? (pb_[r][d0] & 0xffff0000u) : (pb_[r][d0] << 16));
                    const float v = ((fa + fb) + o[d0][r]) * rl; const float vn = lane_xor_f<1>(v);
                    if ((r32e & 1) == 0) *(unsigned*)(Ow + d0 * 32) = cvt_pk_bf16(v, vn); } }
        }
    }
    __syncthreads();
#undef RESC
#undef KBASE
#undef ACT
#undef MASKT
#undef PSM
#undef FSM
#undef FAR_T
#undef MLOAD
#undef MTOUCH
#undef QINIT
#undef SEAM_K0
#undef HALF_STEP
#undef VROT
}
template <int MODE>
__device__ __forceinline__ bool get_blk(const PhaseP<MODE>& P, int n, int c, int G, Blk& b) {
    if constexpr (MODE == 0) {
        int L = c + n * G;
        if (G == 256) { if (n >= 4) return false; L = (2 * (c & 7) + (n >> 1)) * 64 + (c >> 3) + 32 * (n & 1); }
        if (L >= 1024) return false;
        const int bh = L >> 6, rem = L & 63, nqb = 64 / P.tstep, r = rem / nqb, qb = rem % nqb;
        b.tok0 = (bh >> 3) * SEQ + r; b.h = bh & 7; b.P0 = qb * QB; return true;
    } else {
        int it = c + (n >> 1) * G;
        if (G == 256) { if (n >= 4) return false; it = ((c & 7) + 8 * (n >> 1)) * 32 + (c >> 3); }
        if (it >= 512) return false;
        const int bh = it >> 5, x = it & 31;
        b.tok0 = (bh >> 3) * SEQ; b.h = bh & 7; b.P0 = ((n & 1) ? 63 - x : x) * QB; return true;
    }
}
template <int MODE>
__device__ __forceinline__ void attn_phase(const PhaseP<MODE>& P, char* lds, int c, int G, const int tid) {
    Blk cur, nxt; int n = 0;
    if (!get_blk<MODE>(P, 0, c, G, cur)) return;
    Seam S;
    attn_prime<MODE>(P, cur, lds, S, tid);
    for (;;) {
        const bool more = get_blk<MODE>(P, n + 1, c, G, nxt);
        if (!more) nxt = cur;
        attn_block<MODE>(P, cur, nxt, lds, S, tid);
        if (!more) break;
        cur = nxt; ++n;
    }
    VMW(); __syncthreads();
}
#undef AROW
#undef VMW
#undef VMWN
#undef SLOAD_K
#undef UROW
#undef QLOAD
#undef LANE_OFFS
#undef SLOAD_V
#undef SWRITE_K
#undef SWRITE_V
}

namespace idx {
constexpr int CAP = 448, CHUNK = 128;
constexpr int LDS_KBUF = 0;
constexpr int LDS_CAND = 32768;
constexpr int LDS_BITS = 32768;
constexpr int IDX_LDS = LDS_CAND + 32 * CAP * 8;
constexpr float IDX_SCALE = 0.03125f;
__device__ __forceinline__ unsigned fkey(float f) { const unsigned b = __float_as_uint(f); return b ^ ((unsigned)((int)b >> 31) | 0x80000000u); }
__device__ __forceinline__ float fkey_inv(unsigned k) { return __uint_as_float((k & 0x80000000u) ? (k ^ 0x80000000u) : ~k); }
typedef unsigned long long u64;
__device__ __forceinline__ int count_ge(const u64 (&e)[7], u64 mid) {
    int c = 0;
#pragma unroll
    for (int j = 0; j < 7; ++j) c += __popcll(__ballot(e[j] >= mid));
    return c;
}
__device__ __forceinline__ u64 bisect(const u64 (&e)[7], u64 lo, int ksel, int thi) {
    unsigned mk = 0;
#pragma unroll
    for (int j = 0; j < 7; ++j) { const unsigned k = (unsigned)(e[j] >> 32); mk = k > mk ? k : mk; }
    mk = (unsigned)__builtin_amdgcn_readfirstlane((int)wave_max_u(mk));
    u64 hi = ((u64)mk << 32) | 0xffffffffull;
    for (int it = 0; it < 80; ++it) {
        if (hi - lo <= 1ull) break;
        const u64 mid = lo + ((hi - lo) >> 1);
        const int c = count_ge(e, mid);
        if (c >= ksel) { lo = mid; if (c <= thi) break; } else hi = mid;
    }
    return lo;
}
__device__ __forceinline__ int count_ge32(const unsigned (&k)[7], unsigned mid) {
    int c = 0;
#pragma unroll
    for (int j = 0; j < 7; ++j) c += __popcll(__builtin_amdgcn_uicmp(k[j], mid, 35  ));
    return c;
}
template <int Q>
__device__ __forceinline__ void compact(char* cand, int wid, int lane, int (&cnt)[4], float (&thr)[4], const int ksel) {
    u64* base = (u64*)(cand + (size_t)(4 * wid + Q) * CAP * 8);
    const int n = cnt[Q];
    u64 e[7]; unsigned k[7];
#pragma unroll
    for (int j = 0; j < 7; ++j) { const int i = lane + 64 * j; e[j] = (i < n) ? base[i] : 0ull; k[j] = (unsigned)(e[j] >> 32); }
    unsigned mk = 0;
#pragma unroll
    for (int j = 0; j < 7; ++j) mk = k[j] > mk ? k[j] : mk;
    unsigned hi = (unsigned)__builtin_amdgcn_readfirstlane((int)wave_max_u(mk));
    unsigned lo = (unsigned)__builtin_amdgcn_readfirstlane((int)fkey(thr[Q]));
    for (int it = 0; it < 40; ++it) {
        if (hi - lo <= 1u) break;
        const unsigned mid = lo + ((hi - lo) >> 1);
        const int c = count_ge32(k, mid);
        if (c >= ksel) { lo = mid; if (c <= ksel + 64) break; } else hi = mid;
    }
    int pos = 0;
#pragma unroll
    for (int j = 0; j < 7; ++j) { const u64 mkk = __builtin_amdgcn_uicmp(k[j], lo, 35);
        const int pre = __builtin_amdgcn_mbcnt_hi((unsigned)(mkk >> 32), __builtin_amdgcn_mbcnt_lo((unsigned)mkk, 0));
        if (k[j] >= lo) base[pos + pre] = e[j];
        pos += __popcll(mkk); }
    cnt[Q] = pos; thr[Q] = fkey_inv(lo);
    if (pos > CAP - 32) {
#pragma unroll
        for (int j = 0; j < 7; ++j) { const int i = lane + 64 * j; e[j] = (i < pos) ? base[i] : 0ull; }
        const u64 T = bisect(e, (u64)lo << 32, ksel, ksel + 32);
        int p2 = 0;
#pragma unroll
        for (int j = 0; j < 7; ++j) { const bool keep = e[j] >= T; const u64 mk2 = __ballot(keep);
            const int pre = __builtin_amdgcn_mbcnt_hi((unsigned)(mk2 >> 32), __builtin_amdgcn_mbcnt_lo((unsigned)mk2, 0));
            if (keep) base[p2 + pre] = e[j];
            p2 += __popcll(mk2); }
        cnt[Q] = p2; thr[Q] = fkey_inv((unsigned)(T >> 32));
    }
}
template <int Q>
__device__ __forceinline__ void final_select(char* cand, int wid, int lane, const int (&cnt)[4], const float (&thr)[4], unsigned (&sel)[4][7]) {
    const u64* base = (const u64*)(cand + (size_t)(4 * wid + Q) * CAP * 8);
    const int n = cnt[Q];
    u64 e[7];
#pragma unroll
    for (int j = 0; j < 7; ++j) { const int i = lane + 64 * j; e[j] = (i < n) ? base[i] : 0ull; }
    u64 T = 1ull;
    if (n > TOPK) T = bisect(e, (u64)fkey(thr[Q]) << 32, TOPK, TOPK);
#pragma unroll
    for (int j = 0; j < 7; ++j) sel[Q][j] = (e[j] >= T) ? ~(unsigned)e[j] : 0xffffffffu;
}

template <int Q>
__device__ __forceinline__ float kth_value(char* cand, int wid, int lane, const int (&cnt)[4], const float (&thr)[4], const int ksel) {
    const u64* base = (const u64*)(cand + (size_t)(4 * wid + Q) * CAP * 8);
    const int n = cnt[Q];
    if (n < ksel) return -__builtin_inff();
    u64 e[7];
#pragma unroll
    for (int j = 0; j < 7; ++j) { const int i = lane + 64 * j; e[j] = (i < n) ? base[i] : 0ull; }
    const u64 T = bisect(e, (u64)fkey(thr[Q]) << 32, ksel, ksel);
    return fkey_inv((unsigned)(T >> 32));
}
struct IdxP { const bf16_t* QI; const bf16_t* KI; const bf16_t* WI; unsigned long long* mask; };
__device__ __forceinline__ void idx_item(const IdxP& P, char* lds, int b, int t0, const int tid) {
    const int wid = __builtin_amdgcn_readfirstlane(tid >> 6), lane = tid & 63, c = lane & 31, hi = lane >> 5;
    char* kbuf = lds + LDS_KBUF; char* cand = lds + LDS_CAND;
    const int tq0 = t0 + 4 * wid;
    const size_t brow = (size_t)b * SEQ;
    bf16x8 a[2][4]; float w[2][16];
#pragma unroll
    for (int p = 0; p < 2; ++p) {
        const bf16_t* qp = P.QI + (brow + tq0 + 2 * p + ((c >> 2) & 1)) * 1024 + ((c >> 3) * 4 + (c & 3)) * 64 + 8 * hi;
#pragma unroll
        for (int ks = 0; ks < 4; ++ks) a[p][ks] = *(const bf16x8*)(qp + 16 * ks);
        const u32x4* wp = (const u32x4*)(P.WI + (brow + tq0 + 2 * p + hi) * 16);
#pragma unroll
        for (int i8 = 0; i8 < 2; ++i8) { const u32x4 v = wp[i8];
#pragma unroll
            for (int i = 0; i < 4; ++i) { w[p][8 * i8 + 2 * i] = bf_lo(v[i]) * IDX_SCALE; w[p][8 * i8 + 2 * i + 1] = bf_hi(v[i]) * IDX_SCALE; } }
    }
#pragma unroll
    for (int p = 0; p < 2; ++p) {
#pragma unroll
        for (int ks = 0; ks < 4; ++ks) asm volatile("" :: "v"(a[p][ks]));
#pragma unroll
        for (int i = 0; i < 16; ++i) asm volatile("" :: "v"(w[p][i]));
    }
    int cnt[4] = {0, 0, 0, 0}; float thr[4];
#pragma unroll
    for (int q = 0; q < 4; ++q) thr[q] = -__builtin_inff();
    const int nch = (t0 + 32 + CHUNK - 1) / CHUNK;
    const int pr0 = tid >> 3, pc0 = tid & 7, pr1 = pr0 + 64;
    const int wo0 = pr0 * 128 + ((pc0 ^ ((pr0 >> 1) & 7)) << 4), wo1 = pr1 * 128 + ((pc0 ^ ((pr1 >> 1) & 7)) << 4);
    const bf16_t* kg = P.KI + brow * 64 + (size_t)pr0 * 64 + pc0 * 8;
    bf16x8 s0, s1;
#define IDX_BF(dst, tl_) do { const int row_ = (tl_) * 32 + c; const char* rp_ = kb + row_ * 128; const int sw_ = (row_ >> 1) & 7; \
        _Pragma("unroll") for (int ks = 0; ks < 4; ++ks) dst[ks] = *(const bf16x8*)(rp_ + (((2 * ks + hi) ^ sw_) << 4)); } while (0)
#define IDX_MMA(accv, p_, bfv) do { asm volatile("v_mfma_f32_32x32x16_bf16 %0, %1, %2, 0" : "=&v"(accv) : "v"(a[p_][0]), "v"(bfv[0])); \
        _Pragma("unroll") for (int ks = 1; ks < 4; ++ks) asm volatile("v_mfma_f32_32x32x16_bf16 %0, %1, %2, %0" : "+v"(accv) : "v"(a[p_][ks]), "v"(bfv[ks])); \
        __builtin_amdgcn_sched_barrier(0); } while (0)
#define IDX_SEL(accv, p_, tl_) do { float sc = 0.f; \
        _Pragma("unroll") for (int i = 0; i < 16; ++i) sc = fmaf(w[p_][i], __int_as_float(max(__float_as_int(accv[i]), 0)), sc); \
        const int kb32_ = ch * CHUNK + (tl_) * 32; \
        const u64 m = __builtin_amdgcn_fcmpf(sc, thrv[p_], 3  ) & __builtin_amdgcn_sicmp(kb32_, tc[p_], 41  ); \
        if (m) { \
            const bool pass = (sc >= thrv[p_]) && (kb32_ <= tc[p_]); \
            const unsigned mlo = (unsigned)m, mhi = (unsigned)(m >> 32); \
            const int nlo = __popc(mlo), nhi = __popc(mhi); \
              \
              \
            const int tsel_ = hi ? (cnt[2 * (p_) + 1] - nlo) : cnt[2 * (p_)]; \
            const int slot = __builtin_amdgcn_mbcnt_hi(mhi, __builtin_amdgcn_mbcnt_lo(mlo, tsel_)); \
            if (pass) { u32x2 ent; ent.x = (unsigned)(~kb32_) - (unsigned)c; ent.y = fkey(sc + 0.0f); *(u32x2*)(cbl + (2 * (p_)) * CAP * 8 + slot * 8) = ent; } \
            cnt[2 * (p_)] += nlo; cnt[2 * (p_) + 1] += nhi; \
            if (cnt[2 * (p_)] > CAP - 32) { compact<2 * (p_)>(cand, wid, lane, cnt, thr, ksel); thrv[p_] = hi ? thr[2 * (p_) + 1] : thr[2 * (p_)]; } \
            if (cnt[2 * (p_) + 1] > CAP - 32) { compact<2 * (p_) + 1>(cand, wid, lane, cnt, thr, ksel); thrv[p_] = hi ? thr[2 * (p_) + 1] : thr[2 * (p_)]; } \
        } } while (0)
    float thrv[2] = {-__builtin_inff(), -__builtin_inff()};
    char* const cbl = cand + (size_t)(4 * wid + hi) * CAP * 8;
    const int tc[2] = {tq0 + hi - c, tq0 + 2 + hi - c};
#ifndef IDX_FORCE_REDO
#define IDX_FORCE_REDO 0
#endif
    const bool can_pre = nch >= 32;
    const int nsamp = can_pre ? (nch - 8) / 16 + 1 : 0;
    const float fs = can_pre ? (float)nsamp / (float)nch : 0.f;
    int ksamp = can_pre ? (int)(255.f * fs + 6.0f * sqrtf(255.f * fs * (1.f - fs)) + 2.f) : 0;
    unsigned* flag = (unsigned*)(lds + IDX_LDS);
    for (int attempt = 0; attempt < 2; ++attempt) {
        const bool pre = can_pre && attempt == 0;
        for (int pass = pre ? 0 : 1; pass < 2; ++pass) {
            const int ksel = pass == 0 ? ksamp : TOPK;
            const int first = pass == 0 ? 7 : 0, step = pass == 0 ? 16 : 1;
            if (pass == 0 || !pre) {
#pragma unroll
                for (int q = 0; q < 4; ++q) { cnt[q] = 0; thr[q] = -__builtin_inff(); } }
            thrv[0] = hi ? thr[1] : thr[0]; thrv[1] = hi ? thr[3] : thr[2];
            { const bf16_t* kn = kg + (size_t)first * CHUNK * 64; s0 = *(const bf16x8*)kn; s1 = *(const bf16x8*)(kn + 64 * 64); }
            *(bf16x8*)(kbuf + wo0) = s0; *(bf16x8*)(kbuf + wo1) = s1;
            __syncthreads();
            int it = 0;
            for (int ch = first; ch < nch; ch += step, ++it) {
                const bool more = ch + step < nch;
                if (more) { const bf16_t* kn = kg + (size_t)(ch + step) * CHUNK * 64; s0 = *(const bf16x8*)kn; s1 = *(const bf16x8*)(kn + 64 * 64); }
                const char* kb = kbuf + (it & 1) * 16384;
                bf16x8 bfA[4], bfB[4]; f32x16 accA, accB;
                IDX_BF(bfA, 0); IDX_BF(bfB, 1);
                IDX_MMA(accA, 0, bfA);
                IDX_MMA(accB, 1, bfA); IDX_SEL(accA, 0, 0);
                IDX_MMA(accA, 0, bfB); IDX_SEL(accB, 1, 0); IDX_BF(bfA, 2);
                IDX_MMA(accB, 1, bfB); IDX_SEL(accA, 0, 1);
                IDX_MMA(accA, 0, bfA); IDX_SEL(accB, 1, 1); IDX_BF(bfB, 3);
                IDX_MMA(accB, 1, bfA); IDX_SEL(accA, 0, 2);
                IDX_MMA(accA, 0, bfB); IDX_SEL(accB, 1, 2);
                IDX_MMA(accB, 1, bfB); IDX_SEL(accA, 0, 3);
                IDX_SEL(accB, 1, 3);
                if (more) { char* kw = kbuf + ((it + 1) & 1) * 16384; *(bf16x8*)(kw + wo0) = s0; *(bf16x8*)(kw + wo1) = s1; }
                __syncthreads();
            }
            if (pass == 0) {
                const float v0 = kth_value<0>(cand, wid, lane, cnt, thr, ksel), v1 = kth_value<1>(cand, wid, lane, cnt, thr, ksel);
                const float v2 = kth_value<2>(cand, wid, lane, cnt, thr, ksel), v3 = kth_value<3>(cand, wid, lane, cnt, thr, ksel);
                thr[0] = v0; thr[1] = v1; thr[2] = v2; thr[3] = v3;
#pragma unroll
                for (int q = 0; q < 4; ++q) cnt[q] = 0;
            }
        }
        if (!pre) break;
        bool ok = true;
#pragma unroll
        for (int q = 0; q < 4; ++q) { const int need = (tq0 + q + 1) < TOPK ? (tq0 + q + 1) : TOPK; ok = ok && (cnt[q] >= need); }
        if (IDX_FORCE_REDO && ((t0 >> 5) % 5) == 0) ok = false;
        __syncthreads(); if (tid == 0) *flag = 0u; __syncthreads();
        if (!ok && lane == 0) *flag = 1u;
        __syncthreads(); const unsigned redo = *flag; __syncthreads();
        if (!redo) break;
    }
#undef IDX_BF
#undef IDX_MMA
#undef IDX_SEL
    unsigned sel[4][7];
    final_select<0>(cand, wid, lane, cnt, thr, sel); final_select<1>(cand, wid, lane, cnt, thr, sel);
    final_select<2>(cand, wid, lane, cnt, thr, sel); final_select<3>(cand, wid, lane, cnt, thr, sel);
    __syncthreads();
    unsigned* bits = (unsigned*)(lds + LDS_BITS);
    for (int i = tid; i < 65536 / 16; i += 512) ((u32x4*)bits)[i] = (u32x4){0u, 0u, 0u, 0u};
    __syncthreads();
#pragma unroll
    for (int q = 0; q < 4; ++q)
#pragma unroll
        for (int j = 0; j < 7; ++j) { const unsigned s = sel[q][j];
            if (s != 0xffffffffu) { const unsigned kk = s & 31u, r_ = ((kk >> 3) << 2) | (kk & 3u), hl = (kk >> 2) & 1u, half = (s >> 5) & 1u;
                atomicOr(&bits[((((s >> 6) * 32) + half * 16 + r_) << 1) + hl], 1u << (4 * wid + q)); } }
    __syncthreads();
    const int nb16 = (((t0 >> 8) * 4 + 3) + 1) * 256 / 16;
    u32x4* mo = (u32x4*)(P.mask + mask_off(b, t0 >> 5));
    for (int i = tid; i < nb16; i += 512) mo[i] = ((const u32x4*)bits)[i];
    __syncthreads();
}
__device__ __forceinline__ void idx_phase(const IdxP& P, char* lds, int c, int G, const int tid) {
    for (int i = c; i < 1024; i += G) { const int r = i >> 8, u = i & 255; idx_item(P, lds, r >> 1, ((r & 1) ? 511 - u : u) * 32, tid); }
}
}

struct CvItem { const float* W; const float* gk; bf16_t* WT; int N, K, k0, n0, row0; };
__device__ __forceinline__ void cv_load(const CvItem& I, int lane, f32x4 (&v)[8], float (&g)[8]) {
    const int kr = lane >> 3, c4 = 4 * (lane & 7); const bool ok = I.n0 + c4 < I.N;
    const float* p = I.W + (size_t)(I.k0 + kr) * I.N + I.n0 + c4;
#pragma unroll
    for (int i = 0; i < 8; ++i) v[i] = ok ? *(const f32x4*)(p + (size_t)(8 * i) * I.N) : (f32x4){0.f, 0.f, 0.f, 0.f};
    if (I.gk) {
#pragma unroll
        for (int i = 0; i < 8; ++i) g[i] = I.gk[I.k0 + 8 * i + kr];
    } else {
#pragma unroll
        for (int i = 0; i < 8; ++i) g[i] = 1.0f;
    }
}
__device__ __forceinline__ void cv_emit(const CvItem& I, float* scr, int lane, const f32x4 (&v)[8], const float (&g)[8]) {
    { float* d = scr + (lane >> 3) * 33 + 4 * (lane & 7);
#pragma unroll
      for (int i = 0; i < 8; ++i) { d[i * 8 * 33 + 0] = v[i][0] * g[i]; d[i * 8 * 33 + 1] = v[i][1] * g[i]; d[i * 8 * 33 + 2] = v[i][2] * g[i]; d[i * 8 * 33 + 3] = v[i][3] * g[i]; } }
    LDS_WAIT(); asm volatile("" ::: "memory");
    const int cc = lane & 7;
#pragma unroll
    for (int j = 0; j < 4; ++j) { const int n = (lane >> 3) + 8 * j; const float* s = scr + (8 * cc) * 33 + n;
        u32x4 o; o.x = cvt_pk_bf16(s[0 * 33], s[1 * 33]); o.y = cvt_pk_bf16(s[2 * 33], s[3 * 33]); o.z = cvt_pk_bf16(s[4 * 33], s[5 * 33]); o.w = cvt_pk_bf16(s[6 * 33], s[7 * 33]);
        if (I.n0 + n < I.N) *(u32x4*)(I.WT + (size_t)(I.row0 + n) * I.K + I.k0 + 8 * cc) = o; }
    LDS_WAIT(); asm volatile("" ::: "memory");
}
struct ConvP { const float* w1i; const float* w1o; const float* win; const float* wout; const float* w2i; const float* w2o; const float* g1; const float* gm; const float* g2; unsigned char* ws; };
__device__ __forceinline__ int swiglu_row(int n0) { const int up = n0 >= DFF ? 1 : 0, j = n0 - up * DFF; return 256 * (j >> 7) + 128 * up + (j & 127); }
__device__ __forceinline__ void convert_phase(const ConvP& P, char* lds, int gw, int NGW, int wave, int lane) {
    float* scr = (float*)(lds + wave * 16384);
    constexpr int I_UP = (DM / 64) * (2 * DFF / 32), I_DN = (DFF / 64) * (DM / 32), I_IN = (DM / 64) * ((PROJW + 31) / 32), I_OUT = (DM / 64) * (DM / 32);
    constexpr int NITEMS = 2 * I_UP + 2 * I_DN + I_IN + I_OUT;
    auto decode = [&](int r) -> CvItem {
        CvItem I;
        if (r < 2 * I_UP) { const bool s = r >= I_UP; r -= s ? I_UP : 0; const int nb = 2 * DFF / 32, kb = r / nb, n0 = (r % nb) * 32;
            I.W = s ? P.w2i : P.w1i; I.gk = s ? P.g2 : P.g1; I.WT = (bf16_t*)(P.ws + (s ? WS_W2I : WS_W1I)); I.N = 2 * DFF; I.K = DM; I.k0 = kb * 64; I.n0 = n0; I.row0 = swiglu_row(n0); return I; }
        r -= 2 * I_UP;
        if (r < 2 * I_DN) { const bool s = r >= I_DN; r -= s ? I_DN : 0; const int nb = DM / 32, kb = r / nb, n0 = (r % nb) * 32;
            I.W = s ? P.w2o : P.w1o; I.gk = nullptr; I.WT = (bf16_t*)(P.ws + (s ? WS_W2O : WS_W1O)); I.N = DM; I.K = DFF; I.k0 = kb * 64; I.n0 = n0; I.row0 = n0; return I; }
        r -= 2 * I_DN;
        if (r < I_IN) { const int nb = (PROJW + 31) / 32, kb = r / nb, n0 = (r % nb) * 32;
            I.W = P.win; I.gk = P.gm; I.WT = (bf16_t*)(P.ws + WS_WIN); I.N = PROJW; I.K = DM; I.k0 = kb * 64; I.n0 = n0; I.row0 = n0; return I; }
        r -= I_IN;
        { const int nb = DM / 32, kb = r / nb, n0 = (r % nb) * 32;
            I.W = P.wout; I.gk = nullptr; I.WT = (bf16_t*)(P.ws + WS_WOUT); I.N = DM; I.K = DM; I.k0 = kb * 64; I.n0 = n0; I.row0 = n0; return I; }
    };
    {
        f32x4 va[8], vb[8]; float ga[8], gb[8];
        int it = gw; CvItem ia{}, ib{};
        if (it < NITEMS) { ia = decode(it); cv_load(ia, lane, va, ga); }
        if (it + NGW < NITEMS) { ib = decode(it + NGW); cv_load(ib, lane, vb, gb); }
        while (it < NITEMS) {
            { const CvItem cur = ia; cv_emit(cur, scr, lane, va, ga); if (it + 2 * NGW < NITEMS) { ia = decode(it + 2 * NGW); cv_load(ia, lane, va, ga); } }
            it += NGW; if (it >= NITEMS) break;
            { const CvItem cur = ib; cv_emit(cur, scr, lane, vb, gb); if (it + 2 * NGW < NITEMS) { ib = decode(it + 2 * NGW); cv_load(ib, lane, vb, gb); } }
            it += NGW;
        }
    }
    { u32x4* z = (u32x4*)((bf16_t*)(P.ws + WS_WIN) + (size_t)PROJW * DM); const int n16 = (PROJP - PROJW) * DM * 2 / 16;
      for (int i = gw * 64 + lane; i < n16; i += NGW * 64) z[i] = (u32x4){0u, 0u, 0u, 0u}; }
}
__device__ __forceinline__ int rel_bucket(int d) {
    if (d < 16) return d;
    const int th[15] = {22, 30, 40, 54, 73, 99, 134, 182, 246, 332, 450, 609, 825, 1117, 1513};
    int b = 16;
#pragma unroll
    for (int i = 0; i < 15; ++i) b += (d >= th[i]) ? 1 : 0;
    return b;
}
__device__ __forceinline__ void table_phase(const float* rel_bias, unsigned char* ws, int gtid, int gstride) {
    float* tabd = (float*)(ws + WS_TABD); float* tabb = (float*)(ws + WS_TABB); float* farb = tabb + 8 * TABB_N;
    const float inv = 1.0f / SCALE;
    for (int i = gtid; i < 3 * 8 * TABD_N; i += gstride) { const int br = i / (8 * TABD_N), h = (i / TABD_N) & 7, step = i % TABD_N - TAB_OFF; const int dil = br == 0 ? 1 : (br == 1 ? 4 : 16);
        tabd[i] = (step >= 0 && step <= 128) ? rel_bias[rel_bucket(step * dil) * 16 + h] * LOG2E : 0.f; }
    for (int i = gtid; i < 8 * TABB_N; i += gstride) { const int h = i / TABB_N, d = i % TABB_N - TAB_OFF;
        tabb[i] = d >= 0 ? rel_bias[rel_bucket(d) * 16 + 8 + h] * LOG2E : 0.f; }
    for (int i = gtid; i < 8; i += gstride) farb[i] = rel_bias[31 * 16 + 8 + i] * LOG2E;
}
__device__ __forceinline__ void xb_phase(const float* x, bf16_t* out, unsigned* ss, int gw, int NGW, int lane) {
    for (int m = gw; m < MROWS; m += NGW) {
        const f32x4* xr = (const f32x4*)(x + (size_t)m * DM) + lane;
        f32x4 v[8]; float s = 0.f;
#pragma unroll
        for (int j = 0; j < 8; ++j) { v[j] = xr[64 * j]; s += (v[j][0] * v[j][0] + v[j][1] * v[j][1]) + (v[j][2] * v[j][2] + v[j][3] * v[j][3]); }
        s = wave_sum(s);
        if (lane == 0) ss[m] = (unsigned)(s * SS_SCALE + 0.5f);
        u32x2* o = (u32x2*)(out + (size_t)m * DM) + lane;
#pragma unroll
        for (int j = 0; j < 8; ++j) { u32x2 wv; wv.x = cvt_pk_bf16(v[j][0], v[j][1]); wv.y = cvt_pk_bf16(v[j][2], v[j][3]); o[64 * j] = wv; }
    }
}
__device__ __forceinline__ void qknorm_phase(unsigned char* ws, const float* gqa, const float* gka, const float* gqb, const float* gkb, int gw, int NGW, int lane) {
    { const bf16_t* t7 = (const bf16_t*)(ws + WS_QA) + 7 * TSTRIDE; bf16_t* kic = (bf16_t*)(ws + WS_KIC); bf16_t* wic = (bf16_t*)(ws + WS_WIC);
      for (int m = gw; m < MROWS; m += NGW) { if (lane < 10) { const u32x4 v = *(const u32x4*)(t7 + (size_t)m * 1024 + lane * 8);
              if (lane < 8) *(u32x4*)(kic + (size_t)m * 64 + lane * 8) = v; else *(u32x4*)(wic + (size_t)m * 16 + (lane - 8) * 8) = v; } } }
    for (int it = gw; it < 4 * MROWS; it += NGW) {
        const int t = it / MROWS, m = it % MROWS;
        const int tsel = t == 0 ? 0 : (t == 1 ? 1 : (t == 2 ? 3 : 4));
        const float* g = t == 0 ? gqa : (t == 1 ? gka : (t == 2 ? gqb : gkb));
        bf16_t* row = (bf16_t*)(ws + WS_QA) + (size_t)tsel * TSTRIDE + (size_t)m * 1024 + lane * 16;
        u32x4 r0 = *(u32x4*)row, r1 = *(u32x4*)(row + 8);
        float v[16];
#pragma unroll
        for (int i = 0; i < 4; ++i) { v[2 * i] = bf_lo(r0[i]); v[2 * i + 1] = bf_hi(r0[i]); v[8 + 2 * i] = bf_lo(r1[i]); v[8 + 2 * i + 1] = bf_hi(r1[i]); }
        float s = 0.f;
#pragma unroll
        for (int i = 0; i < 16; ++i) s += v[i] * v[i];
        s += lane_xor_f<1>(s); s += lane_xor_f<2>(s); s += lane_xor_f<4>(s);
        const float rstd = 1.0f / sqrtf(s * (1.0f / HD) + EPS);
        const float* gp = g + (lane & 7) * 16; const float rs = (t == 2) ? rstd * (SCALE * LOG2E) : rstd;
#pragma unroll
        for (int i = 0; i < 16; ++i) v[i] = v[i] * rs * gp[i];
#pragma unroll
        for (int i = 0; i < 4; ++i) { r0[i] = cvt_pk_bf16(v[2 * i], v[2 * i + 1]); r1[i] = cvt_pk_bf16(v[8 + 2 * i], v[8 + 2 * i + 1]); }
        *(u32x4*)row = r0; *(u32x4*)(row + 8) = r1;
    }
}

constexpr int NPH = 13;
struct Args { const float* in[15]; float* out; unsigned char* ws; int ph_lo, ph_hi; };
typedef const Args __attribute__((address_space(4)))* KArgP;
__device__ __forceinline__ KArgP kargs() { KArgP p = (KArgP)__builtin_amdgcn_kernarg_segment_ptr(); asm volatile("" : "+s"(p)); return p; }
#ifndef PHMASK
#define PHMASK 0xFFFF
#endif
#ifndef REPMASK
#define REPMASK 0
#endif
#define REP(k) for (int rep_ = 0; rep_ < (((REPMASK >> (k)) & 1) ? 2 : 1); ++rep_)
#define IN(k) (((PHMASK >> (k)) & 1) && lo <= base + (k) && base + (k) < hi)
#define SEAM(k) do { if (lo <= base + (k) && base + (k) + 1 < hi) { XcdBarrier bar_; bar_.bar = (unsigned*)(kargs()->ws + WS_CTL) + 1024; bar_.x = xb_xcc_id(); bar_.st = misc + 8; xcd_barrier(bar_); } } while (0)
#define GEOM() const int G = gridDim.x, bx = blockIdx.x; const int tid_ = phase_tid(wave0), lane = tid_ & 63, wave = __builtin_amdgcn_readfirstlane(tid_ >> 6); \
               const int vcu = (G % 8 == 0) ? (bx % 8) * (G / 8) + bx / 8 : bx; const int gw = vcu * 8 + wave, NGW = G * 8; (void)lane; (void)gw; (void)NGW
template <int L>
__device__ __forceinline__ void run_layer(const int lo, const int hi, const int wave0, char* lds, LAS unsigned char* lds_las, volatile LAS unsigned* misc) {
    constexpr int l = L, base = L * NPH;
#define SSP(ws_, k) ((unsigned*)((ws_) + WS_SS) + (size_t)(k) * MROWS)
    if (IN(0)) REP(0) { GEOM(); KArgP ka = kargs(); unsigned char* ws = ka->ws;
        ConvP cp; cp.w1i = ka->in[3] + (size_t)l * DM * 2 * DFF; cp.w1o = ka->in[4] + (size_t)l * DFF * DM; cp.win = ka->in[6] + (size_t)l * DM * PROJW;
        cp.wout = ka->in[11] + (size_t)l * DM * DM; cp.w2i = ka->in[13] + (size_t)l * DM * 2 * DFF; cp.w2o = ka->in[14] + (size_t)l * DFF * DM;
        cp.g1 = ka->in[2] + (size_t)l * DM; cp.gm = ka->in[5] + (size_t)l * DM; cp.g2 = ka->in[12] + (size_t)l * DM; cp.ws = ws;
        convert_phase(cp, lds, gw, NGW, wave, lane);
        if (l == 0) { table_phase(ka->in[1], ws, bx * 512 + tid_, G * 512); xb_phase(ka->in[0], (bf16_t*)(ws + WS_H), SSP(ws, 0), gw, NGW, lane); } }
    SEAM(0);
    if (IN(1)) REP(1) { KArgP ka = kargs(); unsigned char* ws = ka->ws; pg8::Gemm g{(const bf16_t*)(ws + WS_H), (const bf16_t*)(ws + WS_W1I), MROWS, 2 * DFF, DM}; pg8::StaticOrder S; S.init(MROWS, 2 * DFF, gridDim.x, blockIdx.x);
        pg8::EpiSwiglu E{(bf16_t*)(ws + WS_MID), DFF, SSP(ws, 3 * l)}; pg8::gemm_phase<pg8::EpiSwiglu, pg8::StaticOrder, true, true>(lds_las, g, S, E, phase_tid(wave0)); }
    SEAM(1);
    if (IN(2)) { KArgP ka = kargs(); unsigned char* ws = ka->ws; pg8::Gemm g{(const bf16_t*)(ws + WS_MID), (const bf16_t*)(ws + WS_W1O), MROWS, DM, DFF}; pg8::StaticOrder S; S.init(MROWS, DM, gridDim.x, blockIdx.x, true);
        pg8::EpiResid<true> E{l == 0 ? ka->in[0] : ka->out, ka->out, DM, 0.5f, (bf16_t*)(ws + WS_H), SSP(ws, 3 * l + 1)}; pg8::gemm_phase<pg8::EpiResid<true>, pg8::StaticOrder, true, true>(lds_las, g, S, E, phase_tid(wave0)); }
    SEAM(2);
    if (IN(3)) REP(3) { KArgP ka = kargs(); unsigned char* ws = ka->ws; pg8::Gemm g{(const bf16_t*)(ws + WS_H), (const bf16_t*)(ws + WS_WIN), MROWS, PROJP, DM}; pg8::StaticOrder S; S.init(MROWS, PROJP, gridDim.x, blockIdx.x);
        LAS float* X = (LAS float*)(lds_las + 131072);
        { const int t_ = phase_tid(wave0); X[2048 + t_] = (t_ < 128 ? ka->in[7] : (t_ < 256 ? ka->in[8] : (t_ < 384 ? ka->in[9] : ka->in[10])))[l * HD + (t_ & 127)]; __syncthreads(); }
        pg8::EpiProj E{(bf16_t*)(ws + WS_QA), SSP(ws, 3 * l + 1), (bf16_t*)(ws + WS_KIC), (bf16_t*)(ws + WS_WIC), X};
        pg8::gemm_phase<pg8::EpiProj, pg8::StaticOrder, true, true>(lds_las, g, S, E, phase_tid(wave0)); }
    SEAM(3);
    if (IN(5)) REP(5) { KArgP ka = kargs(); unsigned char* ws = ka->ws; bf16_t* T0 = (bf16_t*)(ws + WS_QA);
        idx::IdxP P{T0 + 6 * TSTRIDE, (const bf16_t*)(ws + WS_KIC), (const bf16_t*)(ws + WS_WIC), (unsigned long long*)(ws + WS_MASK) + (size_t)l * 2 * MASK_B}; idx::idx_phase(P, lds, blockIdx.x, gridDim.x, phase_tid(wave0)); }
#define DIL_PHASE(br) do { if (IN(6 + (br))) REP(6 + (br)) { KArgP ka = kargs(); unsigned char* ws = ka->ws; bf16_t* T0 = (bf16_t*)(ws + WS_QA); \
        att::PhaseP<0> P; P.Q = T0; P.K = T0 + TSTRIDE; P.V = T0 + 2 * TSTRIDE; P.tstep = (br) == 0 ? 1 : ((br) == 1 ? 4 : 16); P.skv = SEQ / P.tstep; P.W = 129; \
        P.tab = (const float*)(ws + WS_TABD) + (br) * 8 * TABD_N; P.Oacc = (bf16_t*)(ws + WS_OACC); P.Lacc = (float*)(ws + WS_LACC); P.Oacc2 = (bf16_t*)(ws + WS_OACC2); P.Lacc2 = (float*)(ws + WS_LACC2); P.Out = (bf16_t*)(ws + WS_MIX); P.pass = (br); P.mask = nullptr; P.farb = nullptr; \
        att::attn_phase<0>(P, lds, blockIdx.x, gridDim.x, phase_tid(wave0)); } } while (0)
    DIL_PHASE(0);
    DIL_PHASE(1);
    SEAM(7);
    if (IN(9)) REP(9) { KArgP ka = kargs(); unsigned char* ws = ka->ws; bf16_t* T0 = (bf16_t*)(ws + WS_QA);
        att::PhaseP<1> P; P.Q = T0 + 3 * TSTRIDE; P.K = T0 + 4 * TSTRIDE; P.V = T0 + 5 * TSTRIDE; P.tstep = 1; P.skv = SEQ; P.W = 1 << 30;
        P.tab = (const float*)(ws + WS_TABB); P.Oacc = nullptr; P.Lacc = nullptr; P.Oacc2 = nullptr; P.Lacc2 = nullptr; P.Out = (bf16_t*)(ws + WS_MIX); P.pass = 0; P.mask = (const unsigned long long*)(ws + WS_MASK) + (size_t)l * 2 * MASK_B; P.farb = (const float*)(ws + WS_TABB) + 8 * TABB_N;
        att::attn_phase<1>(P, lds, blockIdx.x, gridDim.x, phase_tid(wave0)); }
    DIL_PHASE(2);
    SEAM(9);
#undef DIL_PHASE
    if (IN(10)) { KArgP ka = kargs(); unsigned char* ws = ka->ws; pg8::Gemm g{(const bf16_t*)(ws + WS_MIX), (const bf16_t*)(ws + WS_WOUT), MROWS, DM, DM}; pg8::StaticOrder S; S.init(MROWS, DM, gridDim.x, blockIdx.x);
        pg8::EpiResid<true> E{ka->out, ka->out, DM, 1.0f, (bf16_t*)(ws + WS_H), SSP(ws, 3 * l + 2)}; pg8::gemm_phase<pg8::EpiResid<true>, pg8::StaticOrder, true, true>(lds_las, g, S, E, phase_tid(wave0)); }
    SEAM(10);
    if (IN(11)) REP(11) { KArgP ka = kargs(); unsigned char* ws = ka->ws; pg8::Gemm g{(const bf16_t*)(ws + WS_H), (const bf16_t*)(ws + WS_W2I), MROWS, 2 * DFF, DM}; pg8::StaticOrder S; S.init(MROWS, 2 * DFF, gridDim.x, blockIdx.x);
        pg8::EpiSwiglu E{(bf16_t*)(ws + WS_MID), DFF, SSP(ws, 3 * l + 2)}; pg8::gemm_phase<pg8::EpiSwiglu, pg8::StaticOrder, true, true>(lds_las, g, S, E, phase_tid(wave0)); }
    SEAM(11);
    if (IN(12)) { KArgP ka = kargs(); unsigned char* ws = ka->ws; pg8::Gemm g{(const bf16_t*)(ws + WS_MID), (const bf16_t*)(ws + WS_W2O), MROWS, DM, DFF}; pg8::StaticOrder S; S.init(MROWS, DM, gridDim.x, blockIdx.x, true);
        pg8::EpiResid<(l + 1 < DEPTH)> E{ka->out, ka->out, DM, 0.5f, (bf16_t*)(ws + WS_H), SSP(ws, l + 1 < DEPTH ? 3 * l + 3 : 0)}; pg8::gemm_phase<pg8::EpiResid<(l + 1 < DEPTH)>, pg8::StaticOrder, true, true>(lds_las, g, S, E, phase_tid(wave0)); }
    SEAM(12);
#undef SSP
}
#undef IN
#undef SEAM
#undef GEOM
__global__ void __launch_bounds__(512, 2) fwd_kernel(Args args_unused) {
    extern __shared__ __attribute__((aligned(16))) unsigned char lds_raw[];
    char* lds = (char*)lds_raw;
    volatile LAS unsigned* misc = (volatile LAS unsigned*)((LAS unsigned char*)lds_raw + MISC_OFF);
    if (threadIdx.x < 64) misc[threadIdx.x] = 0u;
    __syncthreads();
    const int wave0 = __builtin_amdgcn_readfirstlane(threadIdx.x >> 6);
    const int lo = kargs()->ph_lo, hi = kargs()->ph_hi;
    if (hi - lo > 1) (void)xcd_barrier_post((unsigned*)(kargs()->ws + WS_CTL) + 1024, misc + 8);
    run_layer<0>(lo, hi, wave0, lds, (LAS unsigned char*)lds_raw, misc);
    run_layer<1>(lo, hi, wave0, lds, (LAS unsigned char*)lds_raw, misc);
}

extern "C" void kernel_launch(void* const* d_in, const int* in_sizes, int n_in, void* d_out, int out_size, void* d_ws, size_t ws_size, hipStream_t stream) {
    static int grid = 0;
    if (grid == 0) {
        if (n_in != 15 || out_size != MROWS * DM || ws_size < WS_END) { fprintf(stderr, "kernel_launch: unexpected shapes (n_in %d out %d ws %zu)\n", n_in, out_size, ws_size); grid = -1; return; }
        int dev = 0, cus = 0, per_cu = 0;
        if (hipGetDevice(&dev) != hipSuccess || hipDeviceGetAttribute(&cus, hipDeviceAttributeMultiprocessorCount, dev) != hipSuccess) { grid = -1; return; }
        if (hipFuncSetAttribute((const void*)fwd_kernel, hipFuncAttributeMaxDynamicSharedMemorySize, LDS_BYTES) != hipSuccess) { fprintf(stderr, "kernel_launch: hipFuncSetAttribute failed\n"); grid = -1; return; }
        if (hipOccupancyMaxActiveBlocksPerMultiprocessor(&per_cu, (const void*)fwd_kernel, 512, LDS_BYTES) != hipSuccess || per_cu < 1) fprintf(stderr, "kernel_launch: occupancy query reports %d\n", per_cu);
        (void)hipGetLastError();
        grid = cus;
    }
    if (grid < 0) return;
    (void)hipMemsetAsync((char*)d_ws + WS_CTL, 0, CTL_ZERO_BYTES, stream);
    Args a{};
    for (int i = 0; i < 15; ++i) a.in[i] = (const float*)d_in[i];
    a.out = (float*)d_out; a.ws = (unsigned char*)d_ws;
#if MK_ONE_LAUNCH
    a.ph_lo = 0; a.ph_hi = DEPTH * NPH;
    hipLaunchKernelGGL(fwd_kernel, dim3(grid), dim3(512), LDS_BYTES, stream, a);
#else
    for (int p = 0; p < DEPTH * NPH; ++p) { a.ph_lo = p; a.ph_hi = p + 1; hipLaunchKernelGGL(fwd_kernel, dim3(grid), dim3(512), LDS_BYTES, stream, a); }
#endif
}
```
